# Optimizing an MI355X kernel written in HIP

```python
import math
import jax, jax.numpy as jnp
from jax import lax
import numpy as np

D_MODEL = 2048
BATCH = 2
SEQ = 8192
DEPTH = 1

CHUNK = 64
GMLP_BLOCK = 128
Q_BLOCK = 128
MIX_WIDTH = D_MODEL
GMLP_WIDTH = MIX_WIDTH // 2
GMLP_GROUPS = 8
GMLP_GROUP_DIM = GMLP_WIDTH // GMLP_GROUPS
DIFF_WIDTH = MIX_WIDTH - GMLP_WIDTH
DIFF_HEADS = 8
DIFF_V_DIM = DIFF_WIDTH // DIFF_HEADS
DIFF_QK_DIM = DIFF_V_DIM // 2
IN_COLS = 2 * GMLP_WIDTH + 2 * DIFF_HEADS * 2 * DIFF_QK_DIM + DIFF_WIDTH
D_FF = ((8 * D_MODEL // 3 + 255) // 256) * 256
N_MOD = 9
ROPE_THETA = 10000.0
LN_EPS = 1e-5
ALPHA = (2 * DEPTH) ** 0.25
BETA = (8 * DEPTH) ** -0.25
NEG_INF = -1e30

kernel_name = "hybrid_gmlp_diffattn_macaron_deepnorm_adaln"


def layer_norm(x, g, b):
    xf = x.astype(jnp.float32)
    mu = jnp.mean(xf, axis=-1, keepdims=True)
    var = jnp.mean(jnp.square(xf - mu), axis=-1, keepdims=True)
    y = (xf - mu) * lax.rsqrt(var + LN_EPS) * g.astype(jnp.float32) + b.astype(jnp.float32)
    return y.astype(x.dtype)


def rms_norm(x, g):
    xf = x.astype(jnp.float32)
    y = xf * lax.rsqrt(jnp.mean(jnp.square(xf), axis=-1, keepdims=True) + LN_EPS)
    return (y * g.astype(jnp.float32)).astype(x.dtype)


def modulate(x, shift, scale):
    return x * (1 + scale[:, None, :]) + shift[:, None, :]


def swiglu_ffn(h, w_gu, w_down):
    gate, up = jnp.split(h @ w_gu, 2, axis=-1)
    return (jax.nn.silu(gate) * up) @ w_down


def rope(x, cos, sin):
    x1, x2 = jnp.split(x, 2, axis=-1)
    rot = jnp.concatenate([-x2, x1], axis=-1)
    return x * cos[:, None, None, :] + rot * sin[:, None, None, :]


def gmlp_spatial_gating(u, v, ln_g, ln_b, w_s, b_s):
    B, S, _ = u.shape
    nb = S // GMLP_BLOCK
    u = jax.nn.gelu(u)
    v = layer_norm(jax.nn.gelu(v), ln_g, ln_b)
    v = v.reshape(B, nb, GMLP_BLOCK, GMLP_GROUPS, GMLP_GROUP_DIM)
    pos_chunk = jnp.arange(GMLP_BLOCK) // CHUNK
    mask = pos_chunk[None, :] <= pos_chunk[:, None]
    w = jnp.where(mask[None], w_s, jnp.zeros_like(w_s))
    mixed = jnp.einsum('gij,bnjgc->bnigc', w, v) + jnp.transpose(b_s)[None, None, :, :, None]
    out = u.reshape(B, nb, GMLP_BLOCK, GMLP_GROUPS, GMLP_GROUP_DIM) * mixed
    return out.reshape(B, S, GMLP_WIDTH)


def differential_attention(q, k, v, lam, lam_init, sub_g):
    B, S = q.shape[0], q.shape[1]
    nb = S // Q_BLOCK
    k_chunk = jnp.arange(S) // CHUNK
    q_chunk = k_chunk.reshape(nb, Q_BLOCK)
    qb = (q * (DIFF_QK_DIM ** -0.5)).reshape(B, nb, Q_BLOCK, DIFF_HEADS, 2, DIFF_QK_DIM)
    qb = jnp.transpose(qb, (1, 0, 2, 3, 4, 5))

    def one_block(args):
        q_blk, qc = args
        s = jnp.einsum('bqhcd,bkhcd->bhcqk', q_blk, k).astype(jnp.float32)
        mask = k_chunk[None, :] <= qc[:, None]
        s = jnp.where(mask, s, NEG_INF)
        p = jax.nn.softmax(s, axis=-1)
        a = p[:, :, 0] - lam * p[:, :, 1]
        return jnp.einsum('bhqk,bkhd->bqhd', a.astype(v.dtype), v)

    o = lax.map(one_block, (qb, q_chunk))
    o = jnp.transpose(o, (1, 0, 2, 3, 4)).reshape(B, S, DIFF_HEADS, DIFF_V_DIM)
    o = rms_norm(o, sub_g) * (1.0 - lam_init)
    return o.reshape(B, S, DIFF_WIDTH)


def hybrid_mixer(h, w_in, gmlp_ln_g, gmlp_ln_b, gmlp_w_s, gmlp_b_s,
                 lambda_q1, lambda_k1, lambda_q2, lambda_k2, diff_subln_g, w_out, layer_idx):
    B, S, _ = h.shape
    proj = h @ w_in
    c1 = GMLP_WIDTH
    c2 = 2 * GMLP_WIDTH
    c3 = c2 + DIFF_HEADS * 2 * DIFF_QK_DIM
    c4 = c3 + DIFF_HEADS * 2 * DIFF_QK_DIM
    u, vg, q, k, v = jnp.split(proj, [c1, c2, c3, c4], axis=-1)

    out_a = gmlp_spatial_gating(u, vg, gmlp_ln_g, gmlp_ln_b, gmlp_w_s, gmlp_b_s)

    q = q.reshape(B, S, DIFF_HEADS, 2, DIFF_QK_DIM)
    k = k.reshape(B, S, DIFF_HEADS, 2, DIFF_QK_DIM)
    v = v.reshape(B, S, DIFF_HEADS, DIFF_V_DIM)
    pos = jnp.arange(S, dtype=jnp.float32)
    inv_freq = ROPE_THETA ** (-jnp.arange(0, DIFF_QK_DIM, 2, dtype=jnp.float32) / DIFF_QK_DIM)
    ang = pos[:, None] * inv_freq[None, :]
    cos = jnp.concatenate([jnp.cos(ang), jnp.cos(ang)], axis=-1).astype(q.dtype)
    sin = jnp.concatenate([jnp.sin(ang), jnp.sin(ang)], axis=-1).astype(q.dtype)
    q = rope(q, cos, sin)
    k = rope(k, cos, sin)
    lam_init = 0.8 - 0.6 * math.exp(-0.3 * layer_idx)
    lam = (jnp.exp(jnp.sum(lambda_q1.astype(jnp.float32) * lambda_k1.astype(jnp.float32)))
           - jnp.exp(jnp.sum(lambda_q2.astype(jnp.float32) * lambda_k2.astype(jnp.float32)))
           + lam_init)
    out_b = differential_attention(q, k, v, lam, lam_init, diff_subln_g)

    return jnp.concatenate([out_a, out_b], axis=-1) @ w_out


def setup_inputs(seed: int = 0) -> dict:
    key = jax.random.key(seed)
    ks = jax.random.split(key, 32)
    f32 = jnp.float32
    L, D = DEPTH, D_MODEL

    def nrm(k, shape, scale):
        return jax.random.normal(k, shape, f32) * scale

    return {
        "x": nrm(ks[0], (BATCH, SEQ, D), 1.0),
        "c": nrm(ks[1], (BATCH, D), 1.0),
        "w_ada": nrm(ks[2], (L, D, N_MOD * D), 0.1 * D ** -0.5),
        "b_ada": nrm(ks[3], (L, N_MOD * D), 0.02),
        "ffn1_w_gu": nrm(ks[4], (L, D, 2 * D_FF), D ** -0.5),
        "ffn1_w_down": nrm(ks[5], (L, D_FF, D), BETA * D_FF ** -0.5),
        "ln1_g": 1.0 + nrm(ks[6], (L, D), 0.02),
        "ln1_b": nrm(ks[7], (L, D), 0.02),
        "w_in": nrm(ks[8], (L, D, IN_COLS), D ** -0.5),
        "gmlp_ln_g": 1.0 + nrm(ks[9], (L, GMLP_WIDTH), 0.02),
        "gmlp_ln_b": nrm(ks[10], (L, GMLP_WIDTH), 0.02),
        "gmlp_w_s": nrm(ks[11], (L, GMLP_GROUPS, GMLP_BLOCK, GMLP_BLOCK), 0.5 * GMLP_BLOCK ** -0.5),
        "gmlp_b_s": 1.0 + nrm(ks[12], (L, GMLP_GROUPS, GMLP_BLOCK), 0.1),
        "lambda_q1": nrm(ks[13], (L, DIFF_QK_DIM), 0.1),
        "lambda_k1": nrm(ks[14], (L, DIFF_QK_DIM), 0.1),
        "lambda_q2": nrm(ks[15], (L, DIFF_QK_DIM), 0.1),
        "lambda_k2": nrm(ks[16], (L, DIFF_QK_DIM), 0.1),
        "diff_subln_g": 1.0 + nrm(ks[17], (L, DIFF_V_DIM), 0.02),
        "w_out": nrm(ks[18], (L, MIX_WIDTH, D), BETA * MIX_WIDTH ** -0.5),
        "ln2_g": 1.0 + nrm(ks[19], (L, D), 0.02),
        "ln2_b": nrm(ks[20], (L, D), 0.02),
        "ffn2_w_gu": nrm(ks[21], (L, D, 2 * D_FF), D ** -0.5),
        "ffn2_w_down": nrm(ks[22], (L, D_FF, D), BETA * D_FF ** -0.5),
        "ln3_g": 1.0 + nrm(ks[23], (L, D), 0.02),
        "ln3_b": nrm(ks[24], (L, D), 0.02),
    }


def reference(x, c, w_ada, b_ada, ffn1_w_gu, ffn1_w_down, ln1_g, ln1_b,
              w_in, gmlp_ln_g, gmlp_ln_b, gmlp_w_s, gmlp_b_s,
              lambda_q1, lambda_k1, lambda_q2, lambda_k2, diff_subln_g, w_out,
              ln2_g, ln2_b, ffn2_w_gu, ffn2_w_down, ln3_g, ln3_b):
    c_act = jax.nn.silu(c)
    for l in range(DEPTH):
        mod = c_act @ w_ada[l] + b_ada[l]
        s1, sc1, g1, s2, sc2, g2, s3, sc3, g3 = jnp.split(mod, N_MOD, axis=-1)

        h = modulate(x, s1, sc1)
        y = swiglu_ffn(h, ffn1_w_gu[l], ffn1_w_down[l])
        x = layer_norm(ALPHA * x + 0.5 * (1 + g1)[:, None, :] * y, ln1_g[l], ln1_b[l])

        h = modulate(x, s2, sc2)
        y = hybrid_mixer(h, w_in[l], gmlp_ln_g[l], gmlp_ln_b[l], gmlp_w_s[l], gmlp_b_s[l],
                         lambda_q1[l], lambda_k1[l], lambda_q2[l], lambda_k2[l],
                         diff_subln_g[l], w_out[l], l)
        x = layer_norm(ALPHA * x + (1 + g2)[:, None, :] * y, ln2_g[l], ln2_b[l])

        h = modulate(x, s3, sc3)
        y = swiglu_ffn(h, ffn2_w_gu[l], ffn2_w_down[l])
        x = layer_norm(ALPHA * x + 0.5 * (1 + g3)[:, None, :] * y, ln3_g[l], ln3_b[l])
    return x
```

```cpp
#include <hip/hip_runtime.h>
#include <hip/hip_cooperative_groups.h>
#include <cstdio>
#include <cstdint>
namespace cg = cooperative_groups;
namespace pg8 {
#define PG8_LAS __attribute__((address_space(3)))
typedef unsigned short bf16_t;
typedef short bf16x8 __attribute__((ext_vector_type(8)));
typedef float f32x4 __attribute__((ext_vector_type(4)));
typedef unsigned u32x4 __attribute__((ext_vector_type(4)));
constexpr int BM = 256, BK = 64, HALF = 128, HTB = HALF * BK * 2  , STAGE_BYTES = 8 * HTB, NXCD = 8, WGM = 8;

__host__ __device__ __forceinline__ int lds_byte(int r, int c) { const int st = (r >> 4) * 2 + (c >> 5), rr = r & 15, cc = c & 31, ob = rr * 64 + cc * 2; return st * 1024 + (ob ^ (((ob >> 9) & 1) << 5)); }
__host__ __device__ __forceinline__ void stage_rc(int b, int& R, int& C) { const int st = b / 1024, sb = b % 1024, swz = sb ^ (((sb >> 9) & 1) << 5); R = (st >> 1) * 16 + swz / 64; C = (st & 1) * 32 + (swz % 64) / 2; }
__host__ __device__ __forceinline__ int perm32(int rho) { const int n = rho >> 4, i = rho & 15; return 8 * (i >> 2) + 4 * n + (i & 3); }

struct Unit { int pm, pn; };
struct Gemm { const bf16_t* A; const bf16_t* Bt; int M, N, K; };

struct StaticOrder {
    int nM, nN, nwg, G, c;
    __host__ __device__ void init(int M, int N, int G_, int c_) { nM = M / BM; nN = N / BM; nwg = nM * nN; G = G_; c = c_; }
    __host__ __device__ bool next(int i, Unit& u) const {
        const long L = (long)i * G + c; if (L >= nwg) return false;
        int wgid = (int)L; { const int q = nwg / NXCD, r = nwg % NXCD, xcd = wgid % NXCD, off = wgid / NXCD; wgid = (xcd < r ? xcd * (q + 1) : r * (q + 1) + (xcd - r) * q) + off; }
        const int nig = WGM * nN, gid = wgid / nig, fm = gid * WGM, gsz = (nM - fm) < WGM ? (nM - fm) : WGM;
        u.pm = fm + ((wgid % nig) % gsz); u.pn = (wgid % nig) / gsz; return true;
    }
    __device__ __forceinline__ void a_ready(const Unit&) const {}
    __device__ __forceinline__ void done(const Unit&) const {}
};

__device__ __forceinline__ unsigned cvt_pk_bf16(float lo, float hi) { unsigned r; asm volatile("v_cvt_pk_bf16_f32 %0, %1, %2" : "=v"(r) : "v"(lo), "v"(hi)); return r; }
typedef float f32x2 __attribute__((ext_vector_type(2)));
__device__ __forceinline__ f32x2 gelu_pk(f32x2 v) {
    const f32x2 av = __builtin_elementwise_abs(v), d = av * 0.2316418882f + 1.0f;
    f32x2 t; t.x = __builtin_amdgcn_rcpf(d.x); t.y = __builtin_amdgcn_rcpf(d.y);
    f32x2 q = t * 0.5307027145f + (-0.7265760135f); q = q * t + 0.7107068705f; q = q * t + (-0.142248368f); q = q * t + 0.127414796f; q = q * t;
    const f32x2 s = (v * v) * (-0.72134752044f);
    f32x2 e; e.x = __builtin_amdgcn_exp2f(s.x); e.y = __builtin_amdgcn_exp2f(s.y);
    const f32x2 m = v * (q * e), r = v - m;
    f32x2 o; o.x = v.x < 0.f ? m.x : r.x; o.y = v.y < 0.f ? m.y : r.y; return o;
}

template <int ACT  > struct EpiBf16 {
    static constexpr bool PERM = true, AFTER_DRAIN = false; static_assert(ACT == 0 || ACT == 1, "EpiBf16: ACT is 0 (none) or 1 (gelu_pk)");
    bf16_t* O; int ldc; const float* bias; int split_cols; size_t split_stride; float scale0;
    __device__ __forceinline__ void operator()(const f32x4 (&acc)[2][2][4][2], const Unit& u, int wr, int wc, int fr, int fq) const {
        const int row0 = u.pm * BM + wr * 64 + fr; int colt = u.pn * BM; bf16_t* base = O;
        float sc = 1.f; if (split_cols) { const int t = colt / split_cols; base += (size_t)t * split_stride; colt -= t * split_cols; if (t == 0) sc = scale0; }
        const int col0 = colt + wc * 32 + 8 * fq, bcol0 = u.pn * BM + wc * 32 + 8 * fq;
        f32x4 bv[2][2];
#pragma unroll
        for (int bj = 0; bj < 2; ++bj)
#pragma unroll
            for (int n = 0; n < 2; ++n) bv[bj][n] = bias ? *(const f32x4*)(bias + bcol0 + bj * HALF + 4 * n) : (f32x4){0.f, 0.f, 0.f, 0.f};
#pragma unroll
        for (int ai = 0; ai < 2; ++ai)
#pragma unroll
            for (int m = 0; m < 4; ++m) { bf16_t* rowp = base + (size_t)(row0 + ai * HALF + m * 16) * ldc + col0;
#pragma unroll
                for (int bj = 0; bj < 2; ++bj) { f32x4 v0 = acc[ai][bj][m][0] + bv[bj][0], v1 = acc[ai][bj][m][1] + bv[bj][1];
                    if (ACT == 1) { f32x2 a = gelu_pk((f32x2){v0[0], v0[1]}), b = gelu_pk((f32x2){v0[2], v0[3]}), c = gelu_pk((f32x2){v1[0], v1[1]}), d = gelu_pk((f32x2){v1[2], v1[3]});
                        v0 = (f32x4){a.x, a.y, b.x, b.y}; v1 = (f32x4){c.x, c.y, d.x, d.y}; }
                    v0 = v0 * sc; v1 = v1 * sc; u32x4 w; w.x = cvt_pk_bf16(v0[0], v0[1]); w.y = cvt_pk_bf16(v0[2], v0[3]); w.z = cvt_pk_bf16(v1[0], v1[1]); w.w = cvt_pk_bf16(v1[2], v1[3]);
                    *(u32x4*)(rowp + bj * HALF) = w; } }
    }
};

template <class Epi, class Sched, bool ALIGN_EPI = false, bool SP2 = false>
__device__ __forceinline__ void gemm_phase(PG8_LAS unsigned char* lds, const Gemm g, const Sched& S, const Epi& E) {
    int tid_l = threadIdx.x; asm volatile("" : "+v"(tid_l));
    const int tid = tid_l, wid = __builtin_amdgcn_readfirstlane(tid >> 6), lane = tid & 63, wr = wid >> 2, wc = wid & 3, fr = lane & 15, fq = lane >> 4;
    const int K = g.K, nt = K / BK;
    unsigned voffA[2], voffB[2];
#pragma unroll
    for (int i = 0; i < 2; ++i) { int R, C; stage_rc(tid * 16 + i * 8192, R, C); const int Rb = Epi::PERM ? ((R & ~31) + perm32(R & 31)) : R;
        voffA[i] = (unsigned)(R * K + C) * 2u; voffB[i] = (unsigned)(Rb * K + C) * 2u; }
    const size_t kstep = (size_t)(BK * 2);
    const size_t hstep = (size_t)HALF * K * 2;
    const size_t tstep = 2 * hstep;
    const unsigned ldsw = (unsigned)wid * 1024u;
    const int aoff = lds_byte(wr * 64 + fr, fq * 8), boff = lds_byte(wc * 32 + fr, fq * 8);
#define PG8_SA(b, h) (((b) * 2 + (h)) * HTB)
#define PG8_SB(b, h) ((4 + (b) * 2 + (h)) * HTB)
#define PG8_STAGE(bufoff, gbase, voff) do { _Pragma("unroll") for (int _i = 0; _i < 2; ++_i) \
        __builtin_amdgcn_global_load_lds((const unsigned*)((const char*)(gbase) + (voff)[_i]), (PG8_LAS unsigned*)(lds + (bufoff) + ldsw + _i * 8192), 16, 0, 0); } while (0)
#define PG8_LDA(dst, b, h) do { _Pragma("unroll") for (int m = 0; m < 4; ++m) _Pragma("unroll") for (int k = 0; k < 2; ++k) dst[m][k] = *(const PG8_LAS bf16x8*)(lds + PG8_SA(b, h) + aoff + m * 2048 + k * 1024); } while (0)
#define PG8_LDB(dst, b, h) do { _Pragma("unroll") for (int n = 0; n < 2; ++n) _Pragma("unroll") for (int k = 0; k < 2; ++k) dst[n][k] = *(const PG8_LAS bf16x8*)(lds + PG8_SB(b, h) + boff + n * 2048 + k * 1024); } while (0)
#define PG8_MMA(ai, bj, At, Bt) do { __builtin_amdgcn_s_setprio(1); _Pragma("unroll") for (int m = 0; m < 4; ++m) _Pragma("unroll") for (int n = 0; n < 2; ++n) _Pragma("unroll") for (int k = 0; k < 2; ++k) \
        acc[ai][bj][m][n] = __builtin_amdgcn_mfma_f32_16x16x32_bf16(Bt[n][k], At[m][k], acc[ai][bj][m][n], 0, 0, 0); __builtin_amdgcn_s_setprio(0); } while (0)
#define PG8_WAIT_V(n) asm volatile("s_waitcnt vmcnt(" #n ")" ::: "memory")
#define PG8_WAIT_L(n) asm volatile("s_waitcnt lgkmcnt(" #n ")" ::: "memory")
#define PG8_BAR __builtin_amdgcn_s_barrier()
#define PG8_SCHED __builtin_amdgcn_sched_barrier(0)
    Unit cur, nxt; int ui = 0;
    if (!S.next(0, cur)) return;
    f32x4 acc[2][2][4][2];
#pragma unroll
    for (int a = 0; a < 2; ++a)
#pragma unroll
        for (int b = 0; b < 2; ++b)
#pragma unroll
            for (int m = 0; m < 4; ++m)
#pragma unroll
                for (int n = 0; n < 2; ++n) acc[a][b][m][n] = (f32x4){0.f, 0.f, 0.f, 0.f};
    bf16x8 At[4][2], B0[2][2], B1[2][2];
    const char* cA = (const char*)g.A + (size_t)cur.pm * tstep; const char* cB = (const char*)g.Bt + (size_t)cur.pn * tstep;
    S.a_ready(cur);
    if constexpr (SP2) {
        PG8_STAGE(PG8_SB(0, 0), cB, voffB); PG8_STAGE(PG8_SB(0, 1), cB + hstep, voffB); PG8_STAGE(PG8_SA(0, 0), cA, voffA); PG8_STAGE(PG8_SA(0, 1), cA + hstep, voffA);
        if (wr == 1) PG8_BAR;
        PG8_WAIT_V(2); PG8_BAR;
        PG8_STAGE(PG8_SB(1, 0), cB + kstep, voffB); PG8_STAGE(PG8_SA(1, 0), cA + kstep, voffA); PG8_STAGE(PG8_SB(1, 1), cB + hstep + kstep, voffB);
        PG8_WAIT_V(6); PG8_BAR;
    } else {
        PG8_STAGE(PG8_SB(0, 0), cB, voffB); PG8_STAGE(PG8_SA(0, 0), cA, voffA); PG8_STAGE(PG8_SB(0, 1), cB + hstep, voffB); PG8_STAGE(PG8_SA(0, 1), cA + hstep, voffA);
        if (wr == 1) PG8_BAR;
        PG8_WAIT_V(4); PG8_BAR;
        PG8_STAGE(PG8_SB(1, 0), cB + kstep, voffB); PG8_STAGE(PG8_SA(1, 0), cA + kstep, voffA); PG8_STAGE(PG8_SB(1, 1), cB + hstep + kstep, voffB);
        PG8_WAIT_V(6); PG8_BAR;
    }
    for (;;) {
        const bool has_next = S.next(ui + 1, nxt);
        const char* nA = has_next ? (const char*)g.A + (size_t)nxt.pm * tstep : cA; const char* nB = has_next ? (const char*)g.Bt + (size_t)nxt.pn * tstep : cB;
        for (int t = 0; t < nt; t += 2) {
            const bool last = (t == nt - 2);
            const char* a1 = cA + (size_t)(t + 1) * kstep;
            const char* a2 = last ? nA : cA + (size_t)(t + 2) * kstep; const char* b2 = last ? nB : cB + (size_t)(t + 2) * kstep;
            const char* a3 = a2 + kstep; const char* b3 = b2 + kstep;
            if (last && has_next) S.a_ready(nxt);
            if constexpr (SP2) {
            PG8_LDB(B0, 0, 0); PG8_LDB(B1, 0, 1); PG8_SCHED; PG8_LDA(At, 0, 0); PG8_STAGE(PG8_SA(1, 1), a1 + hstep, voffA);
            PG8_WAIT_V(8); PG8_WAIT_L(0); PG8_BAR; PG8_MMA(0, 0, At, B0); PG8_MMA(0, 1, At, B1); PG8_BAR; PG8_SCHED;
            PG8_LDA(At, 0, 1); PG8_STAGE(PG8_SB(0, 0), b2, voffB); PG8_STAGE(PG8_SB(0, 1), b2 + hstep, voffB); PG8_STAGE(PG8_SA(0, 0), a2, voffA);
            PG8_WAIT_V(8); PG8_WAIT_L(0); PG8_BAR; PG8_MMA(1, 0, At, B0); PG8_MMA(1, 1, At, B1); PG8_BAR; PG8_SCHED;
            PG8_LDB(B0, 1, 0); PG8_LDB(B1, 1, 1); PG8_SCHED; PG8_LDA(At, 1, 0); PG8_STAGE(PG8_SA(0, 1), a2 + hstep, voffA);
            PG8_WAIT_V(8); PG8_WAIT_L(0); PG8_BAR; PG8_MMA(0, 0, At, B0); PG8_MMA(0, 1, At, B1); PG8_BAR; PG8_SCHED;
            PG8_LDA(At, 1, 1); PG8_STAGE(PG8_SB(1, 0), b3, voffB); PG8_STAGE(PG8_SB(1, 1), b3 + hstep, voffB); PG8_STAGE(PG8_SA(1, 0), a3, voffA);
            PG8_WAIT_V(8); PG8_WAIT_L(0); PG8_BAR; PG8_MMA(1, 0, At, B0); PG8_MMA(1, 1, At, B1); PG8_BAR; PG8_SCHED;
            } else {
            PG8_LDB(B0, 0, 0); PG8_SCHED; PG8_LDA(At, 0, 0); PG8_STAGE(PG8_SA(1, 1), a1 + hstep, voffA);
            PG8_WAIT_L(8); PG8_BAR; PG8_WAIT_L(0); PG8_MMA(0, 0, At, B0); PG8_BAR; PG8_SCHED;
            PG8_LDB(B1, 0, 1); PG8_STAGE(PG8_SB(0, 0), b2, voffB);
            PG8_BAR; PG8_WAIT_L(0); PG8_MMA(0, 1, At, B1); PG8_BAR;
            PG8_LDA(At, 0, 1); PG8_STAGE(PG8_SA(0, 0), a2, voffA);
            PG8_BAR; PG8_WAIT_L(0); PG8_MMA(1, 0, At, B0); PG8_BAR; PG8_SCHED;
            PG8_STAGE(PG8_SB(0, 1), b2 + hstep, voffB);
            PG8_WAIT_V(6); PG8_BAR; PG8_MMA(1, 1, At, B1); PG8_BAR;
            PG8_LDB(B0, 1, 0); PG8_SCHED; PG8_LDA(At, 1, 0); PG8_STAGE(PG8_SA(0, 1), a2 + hstep, voffA);
            PG8_WAIT_L(8); PG8_BAR; PG8_WAIT_L(0); PG8_MMA(0, 0, At, B0); PG8_BAR; PG8_SCHED;
            PG8_LDB(B1, 1, 1); PG8_STAGE(PG8_SB(1, 0), b3, voffB);
            PG8_BAR; PG8_WAIT_L(0); PG8_MMA(0, 1, At, B1); PG8_BAR;
            PG8_LDA(At, 1, 1); PG8_STAGE(PG8_SA(1, 0), a3, voffA);
            PG8_BAR; PG8_WAIT_L(0); PG8_MMA(1, 0, At, B0); PG8_BAR; PG8_SCHED;
            PG8_STAGE(PG8_SB(1, 1), b3 + hstep, voffB);
            PG8_WAIT_V(6); PG8_BAR; PG8_MMA(1, 1, At, B1); PG8_BAR;
            }
        }
        if constexpr (ALIGN_EPI) { if (wr == 0) PG8_BAR; }
        if constexpr (!Epi::AFTER_DRAIN) { E(acc, cur, wr, wc, fr, fq); S.done(cur); }
        if (!has_next) break;
#pragma unroll
        for (int a = 0; a < 2; ++a)
#pragma unroll
            for (int b = 0; b < 2; ++b)
#pragma unroll
                for (int m = 0; m < 4; ++m)
#pragma unroll
                    for (int n = 0; n < 2; ++n) acc[a][b][m][n] = (f32x4){0.f, 0.f, 0.f, 0.f};
        cur = nxt; cA = nA; cB = nB; ++ui;
        if constexpr (ALIGN_EPI) { if (wr == 1) PG8_BAR; }
    }
    PG8_WAIT_V(0);
    if constexpr (!ALIGN_EPI) { if (wr == 0) PG8_BAR; }
    PG8_BAR;
    if constexpr (Epi::AFTER_DRAIN) { E.fused(acc, cur, wr, wc, fr, fq, lds, wid, lane); S.done(cur); }
#undef PG8_SA
#undef PG8_SB
#undef PG8_STAGE
#undef PG8_LDA
#undef PG8_LDB
#undef PG8_MMA
#undef PG8_WAIT_V
#undef PG8_WAIT_L
#undef PG8_BAR
#undef PG8_SCHED
}
}

namespace pg8 {
__device__ __forceinline__ float silu_f(float g) { return g * __builtin_amdgcn_rcpf(1.0f + __builtin_amdgcn_exp2f(-1.4426950408889634f * g)); }
__device__ __forceinline__ float gelu_tanh_f(float v) { const float in = v * (1.0f + 0.044715f * v * v); return v * __builtin_amdgcn_rcpf(1.0f + __builtin_amdgcn_exp2f(-2.3022082f * in)); }

struct EpiSwiglu {
    static constexpr bool PERM = true, AFTER_DRAIN = false;
    bf16_t* O; int ldc;
    __device__ __forceinline__ void operator()(const f32x4 (&acc)[2][2][4][2], const Unit& u, int wr, int wc, int fr, int fq) const {
        const int row0 = u.pm * BM + wr * 64 + fr, col0 = u.pn * HALF + wc * 32 + 8 * fq;
#pragma unroll
        for (int ai = 0; ai < 2; ++ai)
#pragma unroll
            for (int m = 0; m < 4; ++m) { bf16_t* rowp = O + (size_t)(row0 + ai * HALF + m * 16) * ldc + col0;
                const f32x4 g0 = acc[ai][0][m][0], g1 = acc[ai][0][m][1], u0 = acc[ai][1][m][0], u1 = acc[ai][1][m][1];
                u32x4 w;
                w.x = cvt_pk_bf16(silu_f(g0[0]) * u0[0], silu_f(g0[1]) * u0[1]); w.y = cvt_pk_bf16(silu_f(g0[2]) * u0[2], silu_f(g0[3]) * u0[3]);
                w.z = cvt_pk_bf16(silu_f(g1[0]) * u1[0], silu_f(g1[1]) * u1[1]); w.w = cvt_pk_bf16(silu_f(g1[2]) * u1[2], silu_f(g1[3]) * u1[3]);
                *(u32x4*)rowp = w; }
    }
};
struct EpiResid {
    static constexpr bool PERM = false, AFTER_DRAIN = false;
    const float* xres; float* out; const float* gate; float alpha, coef;
    __device__ __forceinline__ void operator()(const f32x4 (&acc)[2][2][4][2], const Unit& u, int wr, int wc, int fr, int fq) const {
        const int row0 = u.pm * BM + wr * 64 + fr, col0 = u.pn * BM + wc * 32 + 4 * fq; const int b = u.pm >> 5;
#pragma unroll
        for (int bj = 0; bj < 2; ++bj)
#pragma unroll
            for (int n = 0; n < 2; ++n) { const f32x4 gv = (*(const f32x4*)(gate + (size_t)b * 18432 + col0 + bj * HALF + n * 16) + 1.0f) * coef;
#pragma unroll
                for (int ai = 0; ai < 2; ++ai)
#pragma unroll
                    for (int m = 0; m < 4; ++m) { const size_t off = (size_t)(row0 + ai * HALF + m * 16) * 2048 + col0 + bj * HALF + n * 16;
                        const f32x4 xr = *(const f32x4*)(xres + off); *(f32x4*)(out + off) = xr * alpha + gv * acc[ai][bj][m][n]; } }
    }
};
struct EpiProj {
    static constexpr bool PERM = true, AFTER_DRAIN = false;
    bf16_t* O; int ldc; int gelu_tiles;
    __device__ __forceinline__ void operator()(const f32x4 (&acc)[2][2][4][2], const Unit& u, int wr, int wc, int fr, int fq) const {
        const int row0 = u.pm * BM + wr * 64 + fr, col0 = u.pn * BM + wc * 32 + 8 * fq; const bool act = u.pn < gelu_tiles;
#pragma unroll
        for (int ai = 0; ai < 2; ++ai)
#pragma unroll
            for (int m = 0; m < 4; ++m) { bf16_t* rowp = O + (size_t)(row0 + ai * HALF + m * 16) * ldc + col0;
#pragma unroll
                for (int bj = 0; bj < 2; ++bj) { f32x4 v0 = acc[ai][bj][m][0], v1 = acc[ai][bj][m][1];
                    if (act) {
#pragma unroll
                        for (int e = 0; e < 4; ++e) { v0[e] = gelu_tanh_f(v0[e]); v1[e] = gelu_tanh_f(v1[e]); } }
                    u32x4 w; w.x = cvt_pk_bf16(v0[0], v0[1]); w.y = cvt_pk_bf16(v0[2], v0[3]); w.z = cvt_pk_bf16(v1[0], v1[1]); w.w = cvt_pk_bf16(v1[2], v1[3]);
                    *(u32x4*)(rowp + bj * HALF) = w; } }
    }
};
}

constexpr int BATCH = 2, SEQ = 8192, DM = 2048, MTOK = BATCH * SEQ, DFF = 5632, NMODW = 9 * DM;
constexpr int PROJW = 4096;
constexpr float LN_EPS = 1e-5f, ALPHA = 1.189207115002721f  ;
constexpr float QSCALE = 0.125f * 1.4426950408889634f;
constexpr float LAM_INIT = 0.2f;

constexpr size_t MiB = 1u << 20;
constexpr size_t WS_MOD = 0, WS_WGU1 = 1 * MiB, WS_WD1 = 45 * MiB, WS_WIN = 67 * MiB, WS_WOUT = 87 * MiB, WS_WGU2 = 95 * MiB, WS_WD2 = 139 * MiB;
constexpr size_t WS_H = 161 * MiB, WS_HID = 225 * MiB, WS_PROJ = WS_HID, WS_VT = WS_HID + 128 * MiB, WS_MIX = 401 * MiB, WS_END = 465 * MiB;
static_assert(WS_WGU1 + (size_t)2 * DFF * DM * 2 <= WS_WD1 && WS_WD1 + (size_t)DM * DFF * 2 <= WS_WIN && WS_WIN + (size_t)5120 * DM * 2 <= WS_WOUT && WS_WOUT + (size_t)DM * DM * 2 <= WS_WGU2, "ws map 1");
static_assert(WS_WGU2 + (size_t)2 * DFF * DM * 2 <= WS_WD2 && WS_WD2 + (size_t)DM * DFF * 2 <= WS_H && WS_H + (size_t)MTOK * DM * 2 <= WS_HID && WS_HID + (size_t)MTOK * DFF * 2 <= WS_MIX, "ws map 2");
static_assert(WS_PROJ + (size_t)MTOK * PROJW * 2 <= WS_VT && WS_VT + (size_t)1024 * MTOK * 2 <= WS_MIX && WS_MIX + (size_t)MTOK * DM * 2 <= WS_END, "ws map 3");

constexpr int NWAVES = 8, LDS_BYTES = 147456;

#define LAS __attribute__((address_space(3)))
typedef unsigned short bf16_t;
typedef short bf16x8 __attribute__((ext_vector_type(8)));
typedef float f32x4 __attribute__((ext_vector_type(4)));
typedef float f32x16 __attribute__((ext_vector_type(16)));
typedef unsigned u32x4 __attribute__((ext_vector_type(4)));
typedef unsigned u32x2 __attribute__((ext_vector_type(2)));
typedef float f32x2_t __attribute__((ext_vector_type(2))); typedef __bf16 bf16x2_t __attribute__((ext_vector_type(2)));
__device__ __forceinline__ unsigned pk2(float lo, float hi) { f32x2_t v = {lo, hi}; bf16x2_t b = __builtin_convertvector(v, bf16x2_t); return __builtin_bit_cast(unsigned, b); }
__device__ __forceinline__ float bf_lo(unsigned w) { return __uint_as_float(w << 16); }
__device__ __forceinline__ float bf_hi(unsigned w) { return __uint_as_float(w & 0xffff0000u); }
__device__ __forceinline__ float wave_sum(float v) {
#pragma unroll
    for (int o = 1; o < 64; o <<= 1) v += __shfl_xor(v, o);
    return v;
}
__device__ __forceinline__ float swap_add(float v) { auto rr = __builtin_amdgcn_permlane32_swap(__float_as_uint(v), __float_as_uint(v), false, false); return __uint_as_float(rr[0]) + __uint_as_float(rr[1]); }
__device__ __forceinline__ float swap_max(float v) { auto rr = __builtin_amdgcn_permlane32_swap(__float_as_uint(v), __float_as_uint(v), false, false); return fmaxf(__uint_as_float(rr[0]), __uint_as_float(rr[1])); }
#define LDS_WAIT() asm volatile("s_waitcnt lgkmcnt(0)" ::: "memory")

struct Args { const float* in[25]; float* out; unsigned char* ws; };

__device__ __forceinline__ void transpose_item64(const float* W, int K, int N, bf16_t* WT, int k0, int n0, int dest_row0, LAS float* scr, int lane) {
    const int nq = lane & 15, kr = lane >> 4;
#pragma unroll 4
    for (int i = 0; i < 16; ++i) { const int kk = 4 * i + kr; const f32x4 v = *(const f32x4*)(W + (size_t)(k0 + kk) * N + n0 + 4 * nq);
        LAS float* s = scr + kk * 65 + 4 * nq; s[0] = v[0]; s[1] = v[1]; s[2] = v[2]; s[3] = v[3]; }
    LDS_WAIT(); asm volatile("" ::: "memory");
    const int c = lane & 7;
#pragma unroll
    for (int j = 0; j < 8; ++j) { const int n = (lane >> 3) + 8 * j; const LAS float* s = scr + (8 * c) * 65 + n;
        u32x4 o; o.x = pk2(s[0 * 65], s[1 * 65]); o.y = pk2(s[2 * 65], s[3 * 65]); o.z = pk2(s[4 * 65], s[5 * 65]); o.w = pk2(s[6 * 65], s[7 * 65]);
        *(u32x4*)(WT + (size_t)(dest_row0 + n) * K + k0 + 8 * c) = o; }
    LDS_WAIT(); asm volatile("" ::: "memory");
}
__device__ __forceinline__ int gu_dest_row(int n0) { return n0 < DFF ? 256 * (n0 >> 7) + (n0 & 127) : 256 * ((n0 - DFF) >> 7) + 128 + ((n0 - DFF) & 127); }

__device__ __forceinline__ void p0_prologue(const Args& a, LAS unsigned char* lds, int tid, int lane, int wave) {
    unsigned char* ws = a.ws;
    {
        LAS float* scr = (LAS float*)(lds + wave * 16640);
        const int gw = blockIdx.x * NWAVES + wave, NGW = gridDim.x * NWAVES;
        constexpr int IT_GU = (DM / 64) * (2 * DFF / 64), IT_DN = (DFF / 64) * (DM / 64), IT_IN = (DM / 64) * (5120 / 64), IT_OUT = (DM / 64) * (DM / 64);
        constexpr int NITEMS = 2 * IT_GU + 2 * IT_DN + IT_IN + IT_OUT;
        for (int it = gw; it < NITEMS; it += NGW) {
            int r = it; const float* W; bf16_t* WT; int K, N, mode = 0;
            if (r < IT_GU) { W = a.in[4]; WT = (bf16_t*)(ws + WS_WGU1); K = DM; N = 2 * DFF; mode = 1; }
            else if ((r -= IT_GU) < IT_GU) { W = a.in[21]; WT = (bf16_t*)(ws + WS_WGU2); K = DM; N = 2 * DFF; mode = 1; }
            else if ((r -= IT_GU) < IT_DN) { W = a.in[5]; WT = (bf16_t*)(ws + WS_WD1); K = DFF; N = DM; }
            else if ((r -= IT_DN) < IT_DN) { W = a.in[22]; WT = (bf16_t*)(ws + WS_WD2); K = DFF; N = DM; }
            else if ((r -= IT_DN) < IT_IN) { W = a.in[8]; WT = (bf16_t*)(ws + WS_WIN); K = DM; N = 5120; }
            else { r -= IT_IN; W = a.in[18]; WT = (bf16_t*)(ws + WS_WOUT); K = DM; N = DM; }
            const int nblk = N / 64, kb = r / nblk, nb = r % nblk, n0 = 64 * nb;
            transpose_item64(W, K, N, WT, 64 * kb, n0, mode ? gu_dest_row(n0) : n0, scr, lane);
        }
    }
    __syncthreads();
    if (gridDim.x == 256) {
        const float* c = a.in[1]; const float* wada = a.in[2]; const float* bada = a.in[3]; float* mod = (float*)(ws + WS_MOD);
        LAS float* red = (LAS float*)lds;
        const int n4 = tid % 18, kg = tid / 18, colbase = 72 * blockIdx.x;
        if (kg < 28) {
            f32x4 a0 = {0.f, 0.f, 0.f, 0.f}, a1 = {0.f, 0.f, 0.f, 0.f};
            for (int k = kg; k < DM; k += 28) { const f32x4 w = *(const f32x4*)(wada + (size_t)k * NMODW + colbase + 4 * n4);
                const float c0 = c[k], c1 = c[DM + k]; a0 += w * pg8::silu_f(c0); a1 += w * pg8::silu_f(c1); }
#pragma unroll
            for (int e = 0; e < 4; ++e) { red[(kg * 2 + 0) * 72 + 4 * n4 + e] = a0[e]; red[(kg * 2 + 1) * 72 + 4 * n4 + e] = a1[e]; }
        }
        __syncthreads();
        if (tid < 144) { const int b = tid / 72, col = tid % 72; float s = 0.f;
            for (int g = 0; g < 28; ++g) s += red[(g * 2 + b) * 72 + col];
            mod[(size_t)b * NMODW + colbase + col] = s + bada[colbase + col]; }
        __syncthreads();
    }
}

template <int MODE> __device__ __forceinline__ void row_pass(const float* src, float* xout, bf16_t* hout, const float* lng, const float* lnb, const float* msh, const float* msc, int lane, int wave) {
    const int gw = blockIdx.x * NWAVES + wave, NGW = gridDim.x * NWAVES;
    for (int row = gw; row < MTOK; row += NGW) {
        const int b = row >> 13;
        const f32x4* xr = (const f32x4*)(src + (size_t)row * DM) + lane;
        f32x4 v[8];
#pragma unroll
        for (int j = 0; j < 8; ++j) v[j] = xr[64 * j];
        float mean = 0.f, rstd = 1.f;
        if (MODE >= 1) {
            float s = 0.f;
#pragma unroll
            for (int j = 0; j < 8; ++j) s += (v[j][0] + v[j][1]) + (v[j][2] + v[j][3]);
            mean = wave_sum(s) * (1.0f / DM); float q = 0.f;
#pragma unroll
            for (int j = 0; j < 8; ++j) { const f32x4 d = v[j] - mean; q += (d[0] * d[0] + d[1] * d[1]) + (d[2] * d[2] + d[3] * d[3]); }
            rstd = 1.0f / sqrtf(wave_sum(q) * (1.0f / DM) + LN_EPS);
        }
#pragma unroll
        for (int j = 0; j < 8; ++j) { const int c4 = lane + 64 * j; f32x4 y = v[j];
            if (MODE >= 1) { const f32x4 g = ((const f32x4*)lng)[c4], bb = ((const f32x4*)lnb)[c4]; y = (v[j] - mean) * rstd * g + bb; ((f32x4*)(xout + (size_t)row * DM))[c4] = y; }
            if (MODE != 2) { const f32x4 sc = ((const f32x4*)(msc + (size_t)b * NMODW))[c4], sh = ((const f32x4*)(msh + (size_t)b * NMODW))[c4]; const f32x4 hh = y * (sc + 1.0f) + sh;
                u32x2 w; w.x = pk2(hh[0], hh[1]); w.y = pk2(hh[2], hh[3]); ((u32x2*)(hout + (size_t)row * DM))[c4] = w; } }
    }
}

__device__ __forceinline__ void proj_row_pass(bf16_t* PROJ, const float* lng, const float* lnb, int lane, int wave) {
    const int gw = blockIdx.x * NWAVES + wave, NGW = gridDim.x * NWAVES;
    const int sub = lane & 3, comp = lane >> 2;
    float invf[8];
#pragma unroll
    for (int e = 0; e < 8; ++e) invf[e] = (float)exp2(-(double)(8 * sub + e) * 0.41524101186092029);
    f32x4 G[4], Bv[4];
#pragma unroll
    for (int e = 0; e < 4; ++e) { G[e] = ((const f32x4*)lng)[4 * lane + e]; Bv[e] = ((const f32x4*)lnb)[4 * lane + e]; }
    for (int row = gw; row < MTOK; row += NGW) {
        bf16_t* pr = PROJ + (size_t)row * PROJW;
        { u32x4* vp = (u32x4*)(pr + 1024 + 16 * lane); const u32x4 w0 = vp[0], w1 = vp[1]; float x[16];
#pragma unroll
          for (int e = 0; e < 4; ++e) { x[2 * e] = bf_lo(w0[e]); x[2 * e + 1] = bf_hi(w0[e]); x[8 + 2 * e] = bf_lo(w1[e]); x[8 + 2 * e + 1] = bf_hi(w1[e]); }
          float s = 0.f;
#pragma unroll
          for (int e = 0; e < 16; ++e) s += x[e];
          const float mean = wave_sum(s) * (1.0f / 1024.0f); float q = 0.f;
#pragma unroll
          for (int e = 0; e < 16; ++e) { x[e] -= mean; q += x[e] * x[e]; }
          const float rstd = 1.0f / sqrtf(wave_sum(q) * (1.0f / 1024.0f) + LN_EPS);
#pragma unroll
          for (int e = 0; e < 16; ++e) x[e] = x[e] * rstd * G[e >> 2][e & 3] + Bv[e >> 2][e & 3];
          u32x4 o0, o1;
#pragma unroll
          for (int e = 0; e < 4; ++e) { o0[e] = pk2(x[2 * e], x[2 * e + 1]); o1[e] = pk2(x[8 + 2 * e], x[8 + 2 * e + 1]); }
          vp[0] = o0; vp[1] = o1; }
        { const float pos = (float)(row & (SEQ - 1)); float cs[8], sn[8];
#pragma unroll
          for (int e = 0; e < 8; ++e) { const float ang = pos * invf[e]; const double rev = (double)ang * 0.15915494309189535; const float fr = (float)(rev - rint(rev));
              cs[e] = __builtin_amdgcn_cosf(fr); sn[e] = __builtin_amdgcn_sinf(fr); }
#pragma unroll
          for (int which = 0; which < 2; ++which) { bf16_t* base = pr + 2048 + which * 1024 + comp * 64 + 8 * sub; const float scl = which == 0 ? QSCALE : 1.0f;
              const u32x4 a = *(const u32x4*)base, bq = *(const u32x4*)(base + 32); u32x4 o1, o2;
#pragma unroll
              for (int e = 0; e < 4; ++e) { const float x1l = bf_lo(a[e]), x1h = bf_hi(a[e]), x2l = bf_lo(bq[e]), x2h = bf_hi(bq[e]);
                  o1[e] = pk2((x1l * cs[2 * e] - x2l * sn[2 * e]) * scl, (x1h * cs[2 * e + 1] - x2h * sn[2 * e + 1]) * scl);
                  o2[e] = pk2((x2l * cs[2 * e] + x1l * sn[2 * e]) * scl, (x2h * cs[2 * e + 1] + x1h * sn[2 * e + 1]) * scl); }
              *(u32x4*)base = o1; *(u32x4*)(base + 32) = o2; } }
    }
}

__device__ __forceinline__ void gmlp_unit(int unit, const bf16_t* PROJ, const float* ws_, const float* bs_, bf16_t* MIX, LAS unsigned char* lds, int tid, int lane, int wave) {
    const int g = unit & 7, tb = unit >> 3; const size_t t0 = (size_t)tb * 128;
    LAS bf16_t* TT = (LAS bf16_t*)lds;
#pragma unroll
    for (int i = 0; i < 4; ++i) { const int p = tid + 512 * i, j = p >> 4, ch = p & 15;
        const u32x4 v = *(const u32x4*)(PROJ + (t0 + j) * PROJW + 1024 + g * 128 + ch * 8);
#pragma unroll
        for (int e = 0; e < 4; ++e) { TT[(ch * 8 + 2 * e) * 136 + j] = (bf16_t)(v[e] & 0xffffu); TT[(ch * 8 + 2 * e + 1) * 136 + j] = (bf16_t)(v[e] >> 16); } }
    __syncthreads();
    const int iq = wave & 3, chh = wave >> 2, r32 = lane & 31, hi = lane >> 5;
    const int ns = iq < 2 ? 4 : 8;
    f32x16 acc[2]; acc[0] = f32x16{}; acc[1] = f32x16{};
    const float* wrow = ws_ + ((size_t)g * 128 + 32 * iq + r32) * 128 + 8 * hi;
    for (int s = 0; s < ns; ++s) {
        const f32x4 w0 = *(const f32x4*)(wrow + 16 * s), w1 = *(const f32x4*)(wrow + 16 * s + 4);
        u32x4 wb; wb.x = pk2(w0[0], w0[1]); wb.y = pk2(w0[2], w0[3]); wb.z = pk2(w1[0], w1[1]); wb.w = pk2(w1[2], w1[3]);
        const bf16x8 bfr = __builtin_bit_cast(bf16x8, wb);
#pragma unroll
        for (int blk = 0; blk < 2; ++blk) { const bf16x8 afr = *(const LAS bf16x8*)(TT + (64 * chh + 32 * blk + r32) * 136 + 16 * s + 8 * hi);
            acc[blk] = __builtin_amdgcn_mfma_f32_32x32x16_bf16(afr, bfr, acc[blk], 0, 0, 0); }
    }
    const int i = 32 * iq + r32; const float bsv = bs_[g * 128 + i];
    const bf16_t* up = PROJ + (t0 + i) * PROJW + g * 128; bf16_t* op = MIX + (t0 + i) * DM + g * 128;
#pragma unroll
    for (int blk = 0; blk < 2; ++blk)
#pragma unroll
        for (int q = 0; q < 4; ++q) { const int c = 64 * chh + 32 * blk + 8 * q + 4 * hi; const u32x2 uu = *(const u32x2*)(up + c);
            u32x2 o; o.x = pk2(bf_lo(uu.x) * (acc[blk][4 * q] + bsv), bf_hi(uu.x) * (acc[blk][4 * q + 1] + bsv)); o.y = pk2(bf_lo(uu.y) * (acc[blk][4 * q + 2] + bsv), bf_hi(uu.y) * (acc[blk][4 * q + 3] + bsv));
            *(u32x2*)(op + c) = o; }
    __syncthreads();
}

__device__ __forceinline__ void attn_unit(int b, int h, int qb, const bf16_t* PROJ, const bf16_t* VT, bf16_t* MIX, float lam, const float* subg, LAS unsigned char* lds, int tid, int lane, int wave) {
    const int r32 = lane & 31, hi = lane >> 5, comp = wave >> 2, wq = wave & 3;
    const size_t tok0 = (size_t)b * SEQ + 128 * qb;
    bf16x8 qr[4];
    { const bf16_t* qp = PROJ + (tok0 + 32 * wq + r32) * PROJW + 2048 + h * 128 + comp * 64 + 8 * hi;
#pragma unroll
      for (int d0 = 0; d0 < 4; ++d0) qr[d0] = *(const bf16x8*)(qp + 16 * d0); }
    const int NT = 2 * qb + 2, my_nt = wq < 2 ? NT - 1 : NT;
    const bf16_t* gK[2]; const bf16_t* gV[2];
#pragma unroll
    for (int i = 0; i < 2; ++i) { const int p = tid + 512 * i;
        { const int krow = (p >> 3) & 63, sw = p & 7, chunk = sw ^ ((krow >> 1) & 7); gK[i] = PROJ + ((size_t)b * SEQ + krow) * PROJW + 3072 + h * 128 + i * 64 + chunk * 8; }
        { const int vrow = p >> 3, sw = p & 7, chunk = sw ^ ((vrow >> 1) & 7); gV[i] = VT + (size_t)(h * 128 + vrow) * MTOK + (size_t)b * SEQ + chunk * 8; } }
    const int pr = (r32 & 19) | ((r32 & 4) << 1) | ((r32 & 8) >> 1);
    int koff[4], voff[4];
#pragma unroll
    for (int d0 = 0; d0 < 4; ++d0) { koff[d0] = comp * 8192 + pr * 128 + (((2 * d0 + hi) ^ ((pr >> 1) & 7)) << 4); voff[d0] = 16384 + r32 * 128 + (((2 * d0 + hi) ^ ((r32 >> 1) & 7)) << 4); }
    f32x16 o[4]; o[0] = f32x16{}; o[1] = f32x16{}; o[2] = f32x16{}; o[3] = f32x16{};
    float m_run = -INFINITY, l_run = 0.f;
    u32x4 kreg[2], vreg[2];
#pragma unroll
    for (int i = 0; i < 2; ++i) { kreg[i] = *(const u32x4*)gK[i]; vreg[i] = *(const u32x4*)gV[i]; }
    for (int t = 0; t < NT; ++t) {
        LAS unsigned char* st = lds + (t & 1) * 32768;
#pragma unroll
        for (int i = 0; i < 2; ++i) { *(LAS u32x4*)(st + (tid + 512 * i) * 16) = kreg[i]; *(LAS u32x4*)(st + 16384 + (tid + 512 * i) * 16) = vreg[i]; }
        __syncthreads();
        if (t + 1 < NT) {
#pragma unroll
            for (int i = 0; i < 2; ++i) { kreg[i] = *(const u32x4*)(gK[i] + (size_t)(t + 1) * 64 * PROJW); vreg[i] = *(const u32x4*)(gV[i] + (size_t)(t + 1) * 64); } }
        if (t < my_nt) {
            f32x16 p0 = f32x16{}, p1 = f32x16{};
#pragma unroll
            for (int d0 = 0; d0 < 4; ++d0) { const bf16x8 a0 = *(const LAS bf16x8*)(st + koff[d0]), a1 = *(const LAS bf16x8*)(st + koff[d0] + 4096);
                p0 = __builtin_amdgcn_mfma_f32_32x32x16_bf16(a0, qr[d0], p0, 0, 0, 0); p1 = __builtin_amdgcn_mfma_f32_32x32x16_bf16(a1, qr[d0], p1, 0, 0, 0); }
            float mx = fmaxf(p0[0], p1[0]);
#pragma unroll
            for (int r = 1; r < 16; ++r) mx = fmaxf(mx, fmaxf(p0[r], p1[r]));
            mx = swap_max(mx);
            const float m_new = fmaxf(m_run, mx), alpha = __builtin_amdgcn_exp2f(m_run - m_new); m_run = m_new;
            float ls = 0.f;
#pragma unroll
            for (int r = 0; r < 16; ++r) { p0[r] = __builtin_amdgcn_exp2f(p0[r] - m_new); p1[r] = __builtin_amdgcn_exp2f(p1[r] - m_new); ls += p0[r] + p1[r]; }
            l_run = l_run * alpha + ls;
#pragma unroll
            for (int blk = 0; blk < 4; ++blk)
#pragma unroll
                for (int r = 0; r < 16; ++r) o[blk][r] *= alpha;
            bf16x8 pf[4];
            { u32x4 w; w.x = pk2(p0[0], p0[1]); w.y = pk2(p0[2], p0[3]); w.z = pk2(p0[4], p0[5]); w.w = pk2(p0[6], p0[7]); pf[0] = __builtin_bit_cast(bf16x8, w);
              w.x = pk2(p0[8], p0[9]); w.y = pk2(p0[10], p0[11]); w.z = pk2(p0[12], p0[13]); w.w = pk2(p0[14], p0[15]); pf[1] = __builtin_bit_cast(bf16x8, w);
              w.x = pk2(p1[0], p1[1]); w.y = pk2(p1[2], p1[3]); w.z = pk2(p1[4], p1[5]); w.w = pk2(p1[6], p1[7]); pf[2] = __builtin_bit_cast(bf16x8, w);
              w.x = pk2(p1[8], p1[9]); w.y = pk2(p1[10], p1[11]); w.z = pk2(p1[12], p1[13]); w.w = pk2(p1[14], p1[15]); pf[3] = __builtin_bit_cast(bf16x8, w); }
#pragma unroll
            for (int blk = 0; blk < 4; ++blk)
#pragma unroll
                for (int s = 0; s < 4; ++s) { const bf16x8 vf = *(const LAS bf16x8*)(st + voff[s] + blk * 4096); o[blk] = __builtin_amdgcn_mfma_f32_32x32x16_bf16(vf, pf[s], o[blk], 0, 0, 0); }
        }
    }
    const float l_tot = swap_add(l_run); float inv = 1.0f / l_tot; if (comp == 1) inv *= lam;
    LAS float* comb = (LAS float*)(lds + 65536);
    if (comp == 1) {
#pragma unroll
        for (int blk = 0; blk < 4; ++blk)
#pragma unroll
            for (int q = 0; q < 4; ++q) { f32x4 v = {o[blk][4 * q] * inv, o[blk][4 * q + 1] * inv, o[blk][4 * q + 2] * inv, o[blk][4 * q + 3] * inv};
                *(LAS f32x4*)(comb + (32 * wq + r32) * 132 + 32 * blk + 8 * q + 4 * hi) = v; }
    }
    __syncthreads();
    if (comp == 0) {
        float ss = 0.f;
#pragma unroll
        for (int blk = 0; blk < 4; ++blk)
#pragma unroll
            for (int q = 0; q < 4; ++q) { const f32x4 c = *(const LAS f32x4*)(comb + (32 * wq + r32) * 132 + 32 * blk + 8 * q + 4 * hi);
#pragma unroll
                for (int e = 0; e < 4; ++e) { const float d = o[blk][4 * q + e] * inv - c[e]; o[blk][4 * q + e] = d; ss += d * d; } }
        ss = swap_add(ss);
        const float rn = (1.0f - LAM_INIT) / sqrtf(ss * (1.0f / 128.0f) + LN_EPS);
        bf16_t* op = MIX + (tok0 + 32 * wq + r32) * DM + 1024 + h * 128;
#pragma unroll
        for (int blk = 0; blk < 4; ++blk)
#pragma unroll
            for (int q = 0; q < 4; ++q) { const int dv = 32 * blk + 8 * q + 4 * hi; const f32x4 sg = *(const f32x4*)(subg + dv);
                u32x2 w; w.x = pk2(o[blk][4 * q] * rn * sg[0], o[blk][4 * q + 1] * rn * sg[1]); w.y = pk2(o[blk][4 * q + 2] * rn * sg[2], o[blk][4 * q + 3] * rn * sg[3]);
                *(u32x2*)(op + dv) = w; }
    }
    __syncthreads();
}

#define GEMM_MULTI(EPI, g, E) do { int bx_ = blockIdx.x; asm volatile("" : "+s"(bx_)); pg8::StaticOrder S_; S_.init((g).M, (g).N, (int)gridDim.x, bx_); pg8::gemm_phase<EPI, pg8::StaticOrder, true, true>(lds3, g, S_, E); } while (0)

__global__ void __launch_bounds__(NWAVES * 64, 2) fwd_megakernel(Args args) {
    extern __shared__ __attribute__((aligned(16))) unsigned char lds[];
    cg::grid_group grid = cg::this_grid();
    LAS unsigned char* lds3 = (LAS unsigned char*)lds;
    const int tid = threadIdx.x, lane = tid & 63, wave = __builtin_amdgcn_readfirstlane(tid >> 6);
    unsigned char* ws = args.ws;
    float* mod = (float*)(ws + WS_MOD);
    bf16_t* H = (bf16_t*)(ws + WS_H); bf16_t* HID = (bf16_t*)(ws + WS_HID); bf16_t* PROJ = (bf16_t*)(ws + WS_PROJ); bf16_t* VT = (bf16_t*)(ws + WS_VT); bf16_t* MIX = (bf16_t*)(ws + WS_MIX);
    float* out = args.out; const float* x = args.in[0];

    p0_prologue(args, lds3, tid, lane, wave);
    grid.sync();
    row_pass<0>(x, nullptr, H, nullptr, nullptr, mod + 0 * DM, mod + 1 * DM, lane, wave);
    grid.sync();
    { pg8::Gemm g{H, (const bf16_t*)(ws + WS_WGU1), MTOK, 2 * DFF, DM}; pg8::EpiSwiglu E{HID, DFF}; GEMM_MULTI(pg8::EpiSwiglu, g, E); }
    grid.sync();
    { pg8::Gemm g{HID, (const bf16_t*)(ws + WS_WD1), MTOK, DM, DFF}; pg8::EpiResid E{x, out, mod + 2 * DM, ALPHA, 0.5f}; GEMM_MULTI(pg8::EpiResid, g, E); }
    grid.sync();
    row_pass<1>(out, out, H, args.in[6], args.in[7], mod + 3 * DM, mod + 4 * DM, lane, wave);
    grid.sync();
    { pg8::Gemm g{H, (const bf16_t*)(ws + WS_WIN), MTOK, PROJW, DM}; pg8::EpiProj E{PROJ, PROJW, 8}; GEMM_MULTI(pg8::EpiProj, g, E); }
    { pg8::Gemm g{(const bf16_t*)(ws + WS_WIN) + (size_t)PROJW * DM, H, 1024, MTOK, DM}; pg8::EpiProj E{VT, MTOK, 0}; GEMM_MULTI(pg8::EpiProj, g, E); }
    grid.sync();
    proj_row_pass(PROJ, args.in[9], args.in[10], lane, wave);
    grid.sync();
    {
        const int bx = blockIdx.x, G = gridDim.x; const int vcu = (G % 8 == 0) ? (bx % 8) * (G / 8) + bx / 8 : bx;
        float lam;
        { const float a1 = lane < 64 ? args.in[13][lane] * args.in[14][lane] : 0.f, a2 = args.in[15][lane] * args.in[16][lane];
          lam = __expf(wave_sum(a1)) - __expf(wave_sum(a2)) + LAM_INIT; }
        for (int P = vcu; P < 512; P += G) {
            const int bh = P >> 5, s = P & 31;
            attn_unit(bh >> 3, bh & 7, 63 - s, PROJ, VT, MIX, lam, args.in[17], lds3, tid, lane, wave);
            attn_unit(bh >> 3, bh & 7, s, PROJ, VT, MIX, lam, args.in[17], lds3, tid, lane, wave);
        }
        for (int u = vcu; u < 1024; u += G) gmlp_unit(u, PROJ, args.in[11], args.in[12], MIX, lds3, tid, lane, wave);
    }
    grid.sync();
    { pg8::Gemm g{MIX, (const bf16_t*)(ws + WS_WOUT), MTOK, DM, DM}; pg8::EpiResid E{out, out, mod + 5 * DM, ALPHA, 1.0f}; GEMM_MULTI(pg8::EpiResid, g, E); }
    grid.sync();
    row_pass<1>(out, out, H, args.in[19], args.in[20], mod + 6 * DM, mod + 7 * DM, lane, wave);
    grid.sync();
    { pg8::Gemm g{H, (const bf16_t*)(ws + WS_WGU2), MTOK, 2 * DFF, DM}; pg8::EpiSwiglu E{HID, DFF}; GEMM_MULTI(pg8::EpiSwiglu, g, E); }
    grid.sync();
    { pg8::Gemm g{HID, (const bf16_t*)(ws + WS_WD2), MTOK, DM, DFF}; pg8::EpiResid E{out, out, mod + 8 * DM, ALPHA, 0.5f}; GEMM_MULTI(pg8::EpiResid, g, E); }
    grid.sync();
    row_pass<2>(out, out, nullptr, args.in[23], args.in[24], nullptr, nullptr, lane, wave);
}

extern "C" void kernel_launch(void* const* d_in, const int* in_sizes, int n_in, void* d_out, int out_size, void* d_ws, size_t ws_size, hipStream_t stream) {
    static int grid = 0;
    if (grid == 0) {
        if (n_in != 25 || in_sizes[0] != MTOK * DM || out_size != MTOK * DM || ws_size < WS_END) { fprintf(stderr, "kernel_launch: unexpected shapes (n_in %d, in0 %d, out %d, ws %zu)\n", n_in, n_in > 0 ? in_sizes[0] : -1, out_size, ws_size); grid = -1; return; }
        int dev = 0, cus = 0, per_cu = 0;
        hipGetDevice(&dev); hipDeviceGetAttribute(&cus, hipDeviceAttributeMultiprocessorCount, dev);
        if (hipFuncSetAttribute((const void*)fwd_megakernel, hipFuncAttributeMaxDynamicSharedMemorySize, LDS_BYTES) != hipSuccess) { fprintf(stderr, "kernel_launch: hipFuncSetAttribute failed\n"); grid = -1; return; }
        hipOccupancyMaxActiveBlocksPerMultiprocessor(&per_cu, (const void*)fwd_megakernel, NWAVES * 64, LDS_BYTES);
        (void)hipGetLastError();
        if (per_cu < 1) per_cu = 1;
        grid = cus * 1;
    }
    if (grid < 0) return;
    Args a{};
    for (int i = 0; i < 25; ++i) a.in[i] = (const float*)d_in[i];
    a.out = (float*)d_out; a.ws = (unsigned char*)d_ws;
    void* kargs[] = {&a};
    hipError_t e = hipLaunchCooperativeKernel((const void*)fwd_megakernel, dim3(grid), dim3(NWAVES * 64), kargs, LDS_BYTES, stream);
    if (e != hipSuccess) fprintf(stderr, "cooperative launch failed: %s (grid %d)\n", hipGetErrorString(e), grid);
}
```

```cpp
#include <hip/hip_runtime.h>
#include <hip/hip_cooperative_groups.h>
#include <cstdio>
#include <cstdint>
namespace cg = cooperative_groups;

namespace pg8 {
#define PG8_LAS __attribute__((address_space(3)))
typedef unsigned short bf16_t;
typedef short bf16x8 __attribute__((ext_vector_type(8)));
typedef float f32x4 __attribute__((ext_vector_type(4)));
typedef unsigned u32x4 __attribute__((ext_vector_type(4)));
constexpr int BM = 256, BK = 64, HALF = 128, HTB = HALF * BK * 2  , STAGE_BYTES = 8 * HTB, NXCD = 8, WGM = 8;

__host__ __device__ __forceinline__ int lds_byte(int r, int c) { const int st = (r >> 4) * 2 + (c >> 5), rr = r & 15, cc = c & 31, ob = rr * 64 + cc * 2; return st * 1024 + (ob ^ (((ob >> 9) & 1) << 5)); }
__host__ __device__ __forceinline__ void stage_rc(int b, int& R, int& C) { const int st = b / 1024, sb = b % 1024, swz = sb ^ (((sb >> 9) & 1) << 5); R = (st >> 1) * 16 + swz / 64; C = (st & 1) * 32 + (swz % 64) / 2; }
__host__ __device__ __forceinline__ int perm32(int rho) { const int n = rho >> 4, i = rho & 15; return 8 * (i >> 2) + 4 * n + (i & 3); }

struct Unit { int pm, pn; };
struct Gemm { const bf16_t* A; const bf16_t* Bt; int M, N, K; };

struct StaticOrder {
    int nM, nN, nwg, G, c;
    __host__ __device__ void init(int M, int N, int G_, int c_) { nM = M / BM; nN = N / BM; nwg = nM * nN; G = G_; c = c_; }
    __host__ __device__ bool next(int i, Unit& u) const {
        const long L = (long)i * G + c; if (L >= nwg) return false;
        int wgid = (int)L; { const int q = nwg / NXCD, r = nwg % NXCD, xcd = wgid % NXCD, off = wgid / NXCD; wgid = (xcd < r ? xcd * (q + 1) : r * (q + 1) + (xcd - r) * q) + off; }
        const int nig = WGM * nN, gid = wgid / nig, fm = gid * WGM, gsz = (nM - fm) < WGM ? (nM - fm) : WGM;
        u.pm = fm + ((wgid % nig) % gsz); u.pn = (wgid % nig) / gsz; return true;
    }
    __device__ __forceinline__ void a_ready(const Unit&) const {}
    __device__ __forceinline__ void done(const Unit&) const {}
};

__device__ __forceinline__ unsigned cvt_pk_bf16(float lo, float hi) { unsigned r; asm volatile("v_cvt_pk_bf16_f32 %0, %1, %2" : "=v"(r) : "v"(lo), "v"(hi)); return r; }
typedef float f32x2 __attribute__((ext_vector_type(2)));
__device__ __forceinline__ f32x2 gelu_pk(f32x2 v) {
    const f32x2 av = __builtin_elementwise_abs(v), d = av * 0.2316418882f + 1.0f;
    f32x2 t; t.x = __builtin_amdgcn_rcpf(d.x); t.y = __builtin_amdgcn_rcpf(d.y);
    f32x2 q = t * 0.5307027145f + (-0.7265760135f); q = q * t + 0.7107068705f; q = q * t + (-0.142248368f); q = q * t + 0.127414796f; q = q * t;
    const f32x2 s = (v * v) * (-0.72134752044f);
    f32x2 e; e.x = __builtin_amdgcn_exp2f(s.x); e.y = __builtin_amdgcn_exp2f(s.y);
    const f32x2 m = v * (q * e), r = v - m;
    f32x2 o; o.x = v.x < 0.f ? m.x : r.x; o.y = v.y < 0.f ? m.y : r.y; return o;
}

template <int ACT  > struct EpiBf16 {
    static constexpr bool PERM = true, AFTER_DRAIN = false; static_assert(ACT == 0 || ACT == 1, "EpiBf16: ACT is 0 (none) or 1 (gelu_pk)");
    bf16_t* O; int ldc; const float* bias; int split_cols; size_t split_stride; float scale0;
    __device__ __forceinline__ void operator()(const f32x4 (&acc)[2][2][4][2], const Unit& u, int wr, int wc, int fr, int fq) const {
        const int row0 = u.pm * BM + wr * 64 + fr; int colt = u.pn * BM; bf16_t* base = O;
        float sc = 1.f; if (split_cols) { const int t = colt / split_cols; base += (size_t)t * split_stride; colt -= t * split_cols; if (t == 0) sc = scale0; }
        const int col0 = colt + wc * 32 + 8 * fq, bcol0 = u.pn * BM + wc * 32 + 8 * fq;
        f32x4 bv[2][2];
#pragma unroll
        for (int bj = 0; bj < 2; ++bj)
#pragma unroll
            for (int n = 0; n < 2; ++n) bv[bj][n] = bias ? *(const f32x4*)(bias + bcol0 + bj * HALF + 4 * n) : (f32x4){0.f, 0.f, 0.f, 0.f};
#pragma unroll
        for (int ai = 0; ai < 2; ++ai)
#pragma unroll
            for (int m = 0; m < 4; ++m) { bf16_t* rowp = base + (size_t)(row0 + ai * HALF + m * 16) * ldc + col0;
#pragma unroll
                for (int bj = 0; bj < 2; ++bj) { f32x4 v0 = acc[ai][bj][m][0] + bv[bj][0], v1 = acc[ai][bj][m][1] + bv[bj][1];
                    if (ACT == 1) { f32x2 a = gelu_pk((f32x2){v0[0], v0[1]}), b = gelu_pk((f32x2){v0[2], v0[3]}), c = gelu_pk((f32x2){v1[0], v1[1]}), d = gelu_pk((f32x2){v1[2], v1[3]});
                        v0 = (f32x4){a.x, a.y, b.x, b.y}; v1 = (f32x4){c.x, c.y, d.x, d.y}; }
                    v0 = v0 * sc; v1 = v1 * sc; u32x4 w; w.x = cvt_pk_bf16(v0[0], v0[1]); w.y = cvt_pk_bf16(v0[2], v0[3]); w.z = cvt_pk_bf16(v1[0], v1[1]); w.w = cvt_pk_bf16(v1[2], v1[3]);
                    *(u32x4*)(rowp + bj * HALF) = w; } }
    }
};

template <class Epi, class Sched, bool ALIGN_EPI = false, bool SP2 = false>
__device__ __forceinline__ void gemm_phase(PG8_LAS unsigned char* lds, const Gemm g, const Sched& S, const Epi& E) {
    int tid_l = threadIdx.x; asm volatile("" : "+v"(tid_l));
    const int tid = tid_l, wid = __builtin_amdgcn_readfirstlane(tid >> 6), lane = tid & 63, wr = wid >> 2, wc = wid & 3, fr = lane & 15, fq = lane >> 4;
    const int K = g.K, nt = K / BK;
    unsigned voffA[2], voffB[2];
#pragma unroll
    for (int i = 0; i < 2; ++i) { int R, C; stage_rc(tid * 16 + i * 8192, R, C); const int Rb = Epi::PERM ? ((R & ~31) + perm32(R & 31)) : R;
        voffA[i] = (unsigned)(R * K + C) * 2u; voffB[i] = (unsigned)(Rb * K + C) * 2u; }
    const size_t kstep = (size_t)(BK * 2);
    const size_t hstep = (size_t)HALF * K * 2;
    const size_t tstep = 2 * hstep;
    const unsigned ldsw = (unsigned)wid * 1024u;
    const int aoff = lds_byte(wr * 64 + fr, fq * 8), boff = lds_byte(wc * 32 + fr, fq * 8);
#define PG8_SA(b, h) (((b) * 2 + (h)) * HTB)
#define PG8_SB(b, h) ((4 + (b) * 2 + (h)) * HTB)
#define PG8_STAGE(bufoff, gbase, voff) do { _Pragma("unroll") for (int _i = 0; _i < 2; ++_i) \
        __builtin_amdgcn_global_load_lds((const unsigned*)((const char*)(gbase) + (voff)[_i]), (PG8_LAS unsigned*)(lds + (bufoff) + ldsw + _i * 8192), 16, 0, 0); } while (0)
#define PG8_LDA(dst, b, h) do { _Pragma("unroll") for (int m = 0; m < 4; ++m) _Pragma("unroll") for (int k = 0; k < 2; ++k) dst[m][k] = *(const PG8_LAS bf16x8*)(lds + PG8_SA(b, h) + aoff + m * 2048 + k * 1024); } while (0)
#define PG8_LDB(dst, b, h) do { _Pragma("unroll") for (int n = 0; n < 2; ++n) _Pragma("unroll") for (int k = 0; k < 2; ++k) dst[n][k] = *(const PG8_LAS bf16x8*)(lds + PG8_SB(b, h) + boff + n * 2048 + k * 1024); } while (0)
#define PG8_MMA(ai, bj, At, Bt) do { __builtin_amdgcn_s_setprio(1); _Pragma("unroll") for (int m = 0; m < 4; ++m) _Pragma("unroll") for (int n = 0; n < 2; ++n) _Pragma("unroll") for (int k = 0; k < 2; ++k) \
        acc[ai][bj][m][n] = __builtin_amdgcn_mfma_f32_16x16x32_bf16(Bt[n][k], At[m][k], acc[ai][bj][m][n], 0, 0, 0); __builtin_amdgcn_s_setprio(0); } while (0)
#define PG8_WAIT_V(n) asm volatile("s_waitcnt vmcnt(" #n ")" ::: "memory")
#define PG8_WAIT_L(n) asm volatile("s_waitcnt lgkmcnt(" #n ")" ::: "memory")
#define PG8_BAR __builtin_amdgcn_s_barrier()
#define PG8_SCHED __builtin_amdgcn_sched_barrier(0)
    Unit cur, nxt; int ui = 0;
    if (!S.next(0, cur)) return;
    f32x4 acc[2][2][4][2];
#pragma unroll
    for (int a = 0; a < 2; ++a)
#pragma unroll
        for (int b = 0; b < 2; ++b)
#pragma unroll
            for (int m = 0; m < 4; ++m)
#pragma unroll
                for (int n = 0; n < 2; ++n) acc[a][b][m][n] = (f32x4){0.f, 0.f, 0.f, 0.f};
    bf16x8 At[4][2], B0[2][2], B1[2][2];
    const char* cA = (const char*)g.A + (size_t)cur.pm * tstep; const char* cB = (const char*)g.Bt + (size_t)cur.pn * tstep;
    S.a_ready(cur);
    if constexpr (SP2) {
        PG8_STAGE(PG8_SB(0, 0), cB, voffB); PG8_STAGE(PG8_SB(0, 1), cB + hstep, voffB); PG8_STAGE(PG8_SA(0, 0), cA, voffA); PG8_STAGE(PG8_SA(0, 1), cA + hstep, voffA);
        if (wr == 1) PG8_BAR;
        PG8_WAIT_V(2); PG8_BAR;
        PG8_STAGE(PG8_SB(1, 0), cB + kstep, voffB); PG8_STAGE(PG8_SA(1, 0), cA + kstep, voffA); PG8_STAGE(PG8_SB(1, 1), cB + hstep + kstep, voffB);
        PG8_WAIT_V(6); PG8_BAR;
    } else {
        PG8_STAGE(PG8_SB(0, 0), cB, voffB); PG8_STAGE(PG8_SA(0, 0), cA, voffA); PG8_STAGE(PG8_SB(0, 1), cB + hstep, voffB); PG8_STAGE(PG8_SA(0, 1), cA + hstep, voffA);
        if (wr == 1) PG8_BAR;
        PG8_WAIT_V(4); PG8_BAR;
        PG8_STAGE(PG8_SB(1, 0), cB + kstep, voffB); PG8_STAGE(PG8_SA(1, 0), cA + kstep, voffA); PG8_STAGE(PG8_SB(1, 1), cB + hstep + kstep, voffB);
        PG8_WAIT_V(6); PG8_BAR;
    }
    for (;;) {
        const bool has_next = S.next(ui + 1, nxt);
        const char* nA = has_next ? (const char*)g.A + (size_t)nxt.pm * tstep : cA; const char* nB = has_next ? (const char*)g.Bt + (size_t)nxt.pn * tstep : cB;
        for (int t = 0; t < nt; t += 2) {
            const bool last = (t == nt - 2);
            const char* a1 = cA + (size_t)(t + 1) * kstep;
            const char* a2 = last ? nA : cA + (size_t)(t + 2) * kstep; const char* b2 = last ? nB : cB + (size_t)(t + 2) * kstep;
            const char* a3 = a2 + kstep; const char* b3 = b2 + kstep;
            if (last && has_next) S.a_ready(nxt);
            if constexpr (SP2) {
            PG8_LDB(B0, 0, 0); PG8_LDB(B1, 0, 1); PG8_SCHED; PG8_LDA(At, 0, 0); PG8_STAGE(PG8_SA(1, 1), a1 + hstep, voffA);
            PG8_WAIT_V(8); PG8_WAIT_L(0); PG8_BAR; PG8_MMA(0, 0, At, B0); PG8_MMA(0, 1, At, B1); PG8_BAR; PG8_SCHED;
            PG8_LDA(At, 0, 1); PG8_STAGE(PG8_SB(0, 0), b2, voffB); PG8_STAGE(PG8_SB(0, 1), b2 + hstep, voffB); PG8_STAGE(PG8_SA(0, 0), a2, voffA);
            PG8_WAIT_V(8); PG8_WAIT_L(0); PG8_BAR; PG8_MMA(1, 0, At, B0); PG8_MMA(1, 1, At, B1); PG8_BAR; PG8_SCHED;
            PG8_LDB(B0, 1, 0); PG8_LDB(B1, 1, 1); PG8_SCHED; PG8_LDA(At, 1, 0); PG8_STAGE(PG8_SA(0, 1), a2 + hstep, voffA);
            PG8_WAIT_V(8); PG8_WAIT_L(0); PG8_BAR; PG8_MMA(0, 0, At, B0); PG8_MMA(0, 1, At, B1); PG8_BAR; PG8_SCHED;
            PG8_LDA(At, 1, 1); PG8_STAGE(PG8_SB(1, 0), b3, voffB); PG8_STAGE(PG8_SB(1, 1), b3 + hstep, voffB); PG8_STAGE(PG8_SA(1, 0), a3, voffA);
            PG8_WAIT_V(8); PG8_WAIT_L(0); PG8_BAR; PG8_MMA(1, 0, At, B0); PG8_MMA(1, 1, At, B1); PG8_BAR; PG8_SCHED;
            } else {
            PG8_LDB(B0, 0, 0); PG8_SCHED; PG8_LDA(At, 0, 0); PG8_STAGE(PG8_SA(1, 1), a1 + hstep, voffA);
            PG8_WAIT_L(8); PG8_BAR; PG8_WAIT_L(0); PG8_MMA(0, 0, At, B0); PG8_BAR; PG8_SCHED;
            PG8_LDB(B1, 0, 1); PG8_STAGE(PG8_SB(0, 0), b2, voffB);
            PG8_BAR; PG8_WAIT_L(0); PG8_MMA(0, 1, At, B1); PG8_BAR;
            PG8_LDA(At, 0, 1); PG8_STAGE(PG8_SA(0, 0), a2, voffA);
            PG8_BAR; PG8_WAIT_L(0); PG8_MMA(1, 0, At, B0); PG8_BAR; PG8_SCHED;
            PG8_STAGE(PG8_SB(0, 1), b2 + hstep, voffB);
            PG8_WAIT_V(6); PG8_BAR; PG8_MMA(1, 1, At, B1); PG8_BAR;
            PG8_LDB(B0, 1, 0); PG8_SCHED; PG8_LDA(At, 1, 0); PG8_STAGE(PG8_SA(0, 1), a2 + hstep, voffA);
            PG8_WAIT_L(8); PG8_BAR; PG8_WAIT_L(0); PG8_MMA(0, 0, At, B0); PG8_BAR; PG8_SCHED;
            PG8_LDB(B1, 1, 1); PG8_STAGE(PG8_SB(1, 0), b3, voffB);
            PG8_BAR; PG8_WAIT_L(0); PG8_MMA(0, 1, At, B1); PG8_BAR;
            PG8_LDA(At, 1, 1); PG8_STAGE(PG8_SA(1, 0), a3, voffA);
            PG8_BAR; PG8_WAIT_L(0); PG8_MMA(1, 0, At, B0); PG8_BAR; PG8_SCHED;
            PG8_STAGE(PG8_SB(1, 1), b3 + hstep, voffB);
            PG8_WAIT_V(6); PG8_BAR; PG8_MMA(1, 1, At, B1); PG8_BAR;
            }
        }
        if constexpr (ALIGN_EPI) { if (wr == 0) PG8_BAR; }
        if constexpr (!Epi::AFTER_DRAIN) { E(acc, cur, wr, wc, fr, fq); S.done(cur); }
        if (!has_next) break;
#pragma unroll
        for (int a = 0; a < 2; ++a)
#pragma unroll
            for (int b = 0; b < 2; ++b)
#pragma unroll
                for (int m = 0; m < 4; ++m)
#pragma unroll
                    for (int n = 0; n < 2; ++n) acc[a][b][m][n] = (f32x4){0.f, 0.f, 0.f, 0.f};
        cur = nxt; cA = nA; cB = nB; ++ui;
        if constexpr (ALIGN_EPI) { if (wr == 1) PG8_BAR; }
    }
    PG8_WAIT_V(0);
    if constexpr (!ALIGN_EPI) { if (wr == 0) PG8_BAR; }
    PG8_BAR;
    if constexpr (Epi::AFTER_DRAIN) { E.fused(acc, cur, wr, wc, fr, fq, lds, wid, lane); S.done(cur); }
#undef PG8_SA
#undef PG8_SB
#undef PG8_STAGE
#undef PG8_LDA
#undef PG8_LDB
#undef PG8_MMA
#undef PG8_WAIT_V
#undef PG8_WAIT_L
#undef PG8_BAR
#undef PG8_SCHED
}
}

namespace pg8 {
__device__ __forceinline__ float silu_f(float g) { return g * __builtin_amdgcn_rcpf(1.0f + __builtin_amdgcn_exp2f(-1.4426950408889634f * g)); }
__device__ __forceinline__ float gelu_tanh_f(float v) { const float in = v * (1.0f + 0.044715f * v * v); return v * __builtin_amdgcn_rcpf(1.0f + __builtin_amdgcn_exp2f(-2.3022082f * in)); }

struct EpiSwiglu {
    static constexpr bool PERM = true, AFTER_DRAIN = false;
    bf16_t* O; int ldc;
    __device__ __forceinline__ void operator()(const f32x4 (&acc)[2][2][4][2], const Unit& u, int wr, int wc, int fr, int fq) const {
        const int row0 = u.pm * BM + wr * 64 + fr, col0 = u.pn * HALF + wc * 32 + 8 * fq;
#pragma unroll
        for (int ai = 0; ai < 2; ++ai)
#pragma unroll
            for (int m = 0; m < 4; ++m) { bf16_t* rowp = O + (size_t)(row0 + ai * HALF + m * 16) * ldc + col0;
                const f32x4 g0 = acc[ai][0][m][0], g1 = acc[ai][0][m][1], u0 = acc[ai][1][m][0], u1 = acc[ai][1][m][1];
                u32x4 w;
                w.x = cvt_pk_bf16(silu_f(g0[0]) * u0[0], silu_f(g0[1]) * u0[1]); w.y = cvt_pk_bf16(silu_f(g0[2]) * u0[2], silu_f(g0[3]) * u0[3]);
                w.z = cvt_pk_bf16(silu_f(g1[0]) * u1[0], silu_f(g1[1]) * u1[1]); w.w = cvt_pk_bf16(silu_f(g1[2]) * u1[2], silu_f(g1[3]) * u1[3]);
                *(u32x4*)rowp = w; }
    }
};
struct EpiResid {
    static constexpr bool PERM = false, AFTER_DRAIN = false;
    const float* xres; float* out; const float* gate; float alpha, coef;
    __device__ __forceinline__ void operator()(const f32x4 (&acc)[2][2][4][2], const Unit& u, int wr, int wc, int fr, int fq) const {
        const int row0 = u.pm * BM + wr * 64 + fr, col0 = u.pn * BM + wc * 32 + 4 * fq; const int b = u.pm >> 5;
#pragma unroll
        for (int bj = 0; bj < 2; ++bj)
#pragma unroll
            for (int n = 0; n < 2; ++n) { const f32x4 gv = (*(const f32x4*)(gate + (size_t)b * 18432 + col0 + bj * HALF + n * 16) + 1.0f) * coef;
#pragma unroll
                for (int ai = 0; ai < 2; ++ai)
#pragma unroll
                    for (int m = 0; m < 4; ++m) { const size_t off = (size_t)(row0 + ai * HALF + m * 16) * 2048 + col0 + bj * HALF + n * 16;
                        const f32x4 xr = *(const f32x4*)(xres + off); *(f32x4*)(out + off) = xr * alpha + gv * acc[ai][bj][m][n]; } }
    }
};
struct EpiProj {
    static constexpr bool PERM = true, AFTER_DRAIN = false;
    bf16_t* O; int ldc; int gelu_tiles;
    __device__ __forceinline__ void operator()(const f32x4 (&acc)[2][2][4][2], const Unit& u, int wr, int wc, int fr, int fq) const {
        const int row0 = u.pm * BM + wr * 64 + fr, col0 = u.pn * BM + wc * 32 + 8 * fq; const bool act = u.pn < gelu_tiles;
#pragma unroll
        for (int ai = 0; ai < 2; ++ai)
#pragma unroll
            for (int m = 0; m < 4; ++m) { bf16_t* rowp = O + (size_t)(row0 + ai * HALF + m * 16) * ldc + col0;
#pragma unroll
                for (int bj = 0; bj < 2; ++bj) { f32x4 v0 = acc[ai][bj][m][0], v1 = acc[ai][bj][m][1];
                    if (act) {
#pragma unroll
                        for (int e = 0; e < 4; ++e) { v0[e] = gelu_tanh_f(v0[e]); v1[e] = gelu_tanh_f(v1[e]); } }
                    u32x4 w; w.x = cvt_pk_bf16(v0[0], v0[1]); w.y = cvt_pk_bf16(v0[2], v0[3]); w.z = cvt_pk_bf16(v1[0], v1[1]); w.w = cvt_pk_bf16(v1[2], v1[3]);
                    *(u32x4*)(rowp + bj * HALF) = w; } }
    }
};
}

constexpr int BATCH = 2, SEQ = 8192, DM = 2048, MTOK = BATCH * SEQ, DFF = 5632, NMODW = 9 * DM;
constexpr int PROJW = 4096;
constexpr float LN_EPS = 1e-5f, ALPHA = 1.189207115002721f  ;
constexpr float QSCALE = 0.125f * 1.4426950408889634f;
constexpr float LAM_INIT = 0.2f;

constexpr size_t MiB = 1u << 20;
constexpr size_t WS_MOD = 0, WS_WGU1 = 1 * MiB, WS_WD1 = 45 * MiB, WS_WIN = 67 * MiB, WS_WOUT = 87 * MiB, WS_WGU2 = 95 * MiB, WS_WD2 = 139 * MiB;
constexpr size_t WS_H = 161 * MiB, WS_HID = 225 * MiB, WS_PROJ = WS_HID, WS_VT = WS_HID + 128 * MiB, WS_MIX = 401 * MiB, WS_END = 465 * MiB;
static_assert(WS_WGU1 + (size_t)2 * DFF * DM * 2 <= WS_WD1 && WS_WD1 + (size_t)DM * DFF * 2 <= WS_WIN && WS_WIN + (size_t)5120 * DM * 2 <= WS_WOUT && WS_WOUT + (size_t)DM * DM * 2 <= WS_WGU2, "ws map 1");
static_assert(WS_WGU2 + (size_t)2 * DFF * DM * 2 <= WS_WD2 && WS_WD2 + (size_t)DM * DFF * 2 <= WS_H && WS_H + (size_t)MTOK * DM * 2 <= WS_HID && WS_HID + (size_t)MTOK * DFF * 2 <= WS_MIX, "ws map 2");
static_assert(WS_PROJ + (size_t)MTOK * PROJW * 2 <= WS_VT && WS_VT + (size_t)1024 * MTOK * 2 <= WS_MIX && WS_MIX + (size_t)MTOK * DM * 2 <= WS_END, "ws map 3");

constexpr size_t WS_CTL = 512 * 1024, CTL_BYTES = 16384;
constexpr int NWAVES = 8, LDS_BYTES = 147456;

#define LAS __attribute__((address_space(3)))
typedef unsigned short bf16_t;
typedef short bf16x8 __attribute__((ext_vector_type(8)));
typedef float f32x4 __attribute__((ext_vector_type(4)));
typedef float f32x16 __attribute__((ext_vector_type(16)));
typedef unsigned u32x4 __attribute__((ext_vector_type(4)));
typedef unsigned u32x2 __attribute__((ext_vector_type(2)));
typedef float f32x2_t __attribute__((ext_vector_type(2))); typedef __bf16 bf16x2_t __attribute__((ext_vector_type(2)));
__device__ __forceinline__ unsigned pk2(float lo, float hi) { f32x2_t v = {lo, hi}; bf16x2_t b = __builtin_convertvector(v, bf16x2_t); return __builtin_bit_cast(unsigned, b); }
__device__ __forceinline__ float bf_lo(unsigned w) { return __uint_as_float(w << 16); }
__device__ __forceinline__ float bf_hi(unsigned w) { return __uint_as_float(w & 0xffff0000u); }
__device__ __forceinline__ float wave_sum(float v) {
#pragma unroll
    for (int o = 1; o < 64; o <<= 1) v += __shfl_xor(v, o);
    return v;
}
__device__ __forceinline__ float swap_add(float v) { auto rr = __builtin_amdgcn_permlane32_swap(__float_as_uint(v), __float_as_uint(v), false, false); return __uint_as_float(rr[0]) + __uint_as_float(rr[1]); }
__device__ __forceinline__ float swap_max(float v) { auto rr = __builtin_amdgcn_permlane32_swap(__float_as_uint(v), __float_as_uint(v), false, false); return fmaxf(__uint_as_float(rr[0]), __uint_as_float(rr[1])); }
#define LDS_WAIT() asm volatile("s_waitcnt lgkmcnt(0)" ::: "memory")

struct Args { const float* in[25]; float* out; unsigned char* ws; };

__device__ __forceinline__ void transpose_item64(const float* W, int K, int N, bf16_t* WT, int k0, int n0, int dest_row0, LAS float* scr, int lane) {
    const int nq = lane & 15, kr = lane >> 4;
#pragma unroll 4
    for (int i = 0; i < 16; ++i) { const int kk = 4 * i + kr; const f32x4 v = *(const f32x4*)(W + (size_t)(k0 + kk) * N + n0 + 4 * nq);
        LAS float* s = scr + kk * 65 + 4 * nq; s[0] = v[0]; s[1] = v[1]; s[2] = v[2]; s[3] = v[3]; }
    LDS_WAIT(); asm volatile("" ::: "memory");
    const int c = lane & 7;
#pragma unroll
    for (int j = 0; j < 8; ++j) { const int n = (lane >> 3) + 8 * j; const LAS float* s = scr + (8 * c) * 65 + n;
        u32x4 o; o.x = pk2(s[0 * 65], s[1 * 65]); o.y = pk2(s[2 * 65], s[3 * 65]); o.z = pk2(s[4 * 65], s[5 * 65]); o.w = pk2(s[6 * 65], s[7 * 65]);
        *(u32x4*)(WT + (size_t)(dest_row0 + n) * K + k0 + 8 * c) = o; }
    LDS_WAIT(); asm volatile("" ::: "memory");
}
__device__ __forceinline__ int gu_dest_row(int n0) { return n0 < DFF ? 256 * (n0 >> 7) + (n0 & 127) : 256 * ((n0 - DFF) >> 7) + 128 + ((n0 - DFF) & 127); }

__device__ __forceinline__ void p0_prologue(const Args& a, LAS unsigned char* lds, int tid, int lane, int wave) {
    unsigned char* ws = a.ws;
    {
        LAS float* scr = (LAS float*)(lds + wave * 16640);
        const int gw = blockIdx.x * NWAVES + wave, NGW = gridDim.x * NWAVES;
        constexpr int IT_GU = (DM / 64) * (2 * DFF / 64), IT_DN = (DFF / 64) * (DM / 64), IT_IN = (DM / 64) * (5120 / 64), IT_OUT = (DM / 64) * (DM / 64);
        constexpr int NITEMS = 2 * IT_GU + 2 * IT_DN + IT_IN + IT_OUT;
        for (int it = gw; it < NITEMS; it += NGW) {
            int r = it; const float* W; bf16_t* WT; int K, N, mode = 0;
            if (r < IT_GU) { W = a.in[4]; WT = (bf16_t*)(ws + WS_WGU1); K = DM; N = 2 * DFF; mode = 1; }
            else if ((r -= IT_GU) < IT_GU) { W = a.in[21]; WT = (bf16_t*)(ws + WS_WGU2); K = DM; N = 2 * DFF; mode = 1; }
            else if ((r -= IT_GU) < IT_DN) { W = a.in[5]; WT = (bf16_t*)(ws + WS_WD1); K = DFF; N = DM; }
            else if ((r -= IT_DN) < IT_DN) { W = a.in[22]; WT = (bf16_t*)(ws + WS_WD2); K = DFF; N = DM; }
            else if ((r -= IT_DN) < IT_IN) { W = a.in[8]; WT = (bf16_t*)(ws + WS_WIN); K = DM; N = 5120; }
            else { r -= IT_IN; W = a.in[18]; WT = (bf16_t*)(ws + WS_WOUT); K = DM; N = DM; }
            const int nblk = N / 64, kb = r / nblk, nb = r % nblk, n0 = 64 * nb;
            transpose_item64(W, K, N, WT, 64 * kb, n0, mode ? gu_dest_row(n0) : n0, scr, lane);
        }
    }
    __syncthreads();
    if (gridDim.x == 256) {
        const float* c = a.in[1]; const float* wada = a.in[2]; const float* bada = a.in[3]; float* mod = (float*)(ws + WS_MOD);
        LAS float* red = (LAS float*)lds;
        const int n4 = tid % 18, kg = tid / 18, colbase = 72 * blockIdx.x;
        if (kg < 28) {
            f32x4 a0 = {0.f, 0.f, 0.f, 0.f}, a1 = {0.f, 0.f, 0.f, 0.f};
            for (int k = kg; k < DM; k += 28) { const f32x4 w = *(const f32x4*)(wada + (size_t)k * NMODW + colbase + 4 * n4);
                const float c0 = c[k], c1 = c[DM + k]; a0 += w * pg8::silu_f(c0); a1 += w * pg8::silu_f(c1); }
#pragma unroll
            for (int e = 0; e < 4; ++e) { red[(kg * 2 + 0) * 72 + 4 * n4 + e] = a0[e]; red[(kg * 2 + 1) * 72 + 4 * n4 + e] = a1[e]; }
        }
        __syncthreads();
        if (tid < 144) { const int b = tid / 72, col = tid % 72; float s = 0.f;
            for (int g = 0; g < 28; ++g) s += red[(g * 2 + b) * 72 + col];
            mod[(size_t)b * NMODW + colbase + col] = s + bada[colbase + col]; }
        __syncthreads();
    }
}

template <int MODE> __device__ __forceinline__ void row_pass(const float* src, float* xout, bf16_t* hout, const float* lng, const float* lnb, const float* msh, const float* msc, int lane, int wave) {
    const int gw = blockIdx.x * NWAVES + wave, NGW = gridDim.x * NWAVES;
    for (int row = gw; row < MTOK; row += NGW) {
        const int b = row >> 13;
        const f32x4* xr = (const f32x4*)(src + (size_t)row * DM) + lane;
        f32x4 v[8];
#pragma unroll
        for (int j = 0; j < 8; ++j) v[j] = xr[64 * j];
        float mean = 0.f, rstd = 1.f;
        if (MODE >= 1) {
            float s = 0.f;
#pragma unroll
            for (int j = 0; j < 8; ++j) s += (v[j][0] + v[j][1]) + (v[j][2] + v[j][3]);
            mean = wave_sum(s) * (1.0f / DM); float q = 0.f;
#pragma unroll
            for (int j = 0; j < 8; ++j) { const f32x4 d = v[j] - mean; q += (d[0] * d[0] + d[1] * d[1]) + (d[2] * d[2] + d[3] * d[3]); }
            rstd = 1.0f / sqrtf(wave_sum(q) * (1.0f / DM) + LN_EPS);
        }
#pragma unroll
        for (int j = 0; j < 8; ++j) { const int c4 = lane + 64 * j; f32x4 y = v[j];
            if (MODE >= 1) { const f32x4 g = ((const f32x4*)lng)[c4], bb = ((const f32x4*)lnb)[c4]; y = (v[j] - mean) * rstd * g + bb; ((f32x4*)(xout + (size_t)row * DM))[c4] = y; }
            if (MODE != 2) { const f32x4 sc = ((const f32x4*)(msc + (size_t)b * NMODW))[c4], sh = ((const f32x4*)(msh + (size_t)b * NMODW))[c4]; const f32x4 hh = y * (sc + 1.0f) + sh;
                u32x2 w; w.x = pk2(hh[0], hh[1]); w.y = pk2(hh[2], hh[3]); ((u32x2*)(hout + (size_t)row * DM))[c4] = w; } }
    }
}

__device__ __forceinline__ void proj_row_pass(bf16_t* PROJ, const float* lng, const float* lnb, int lane, int wave) {
    const int gw = blockIdx.x * NWAVES + wave, NGW = gridDim.x * NWAVES;
    const int sub = lane & 3, comp = lane >> 2;
    float invf[8];
#pragma unroll
    for (int e = 0; e < 8; ++e) invf[e] = (float)exp2(-(double)(8 * sub + e) * 0.41524101186092029);
    f32x4 G[4], Bv[4];
#pragma unroll
    for (int e = 0; e < 4; ++e) { G[e] = ((const f32x4*)lng)[4 * lane + e]; Bv[e] = ((const f32x4*)lnb)[4 * lane + e]; }
    for (int row = gw; row < MTOK; row += NGW) {
        bf16_t* pr = PROJ + (size_t)row * PROJW;
        { u32x4* vp = (u32x4*)(pr + 1024 + 16 * lane); const u32x4 w0 = vp[0], w1 = vp[1]; float x[16];
#pragma unroll
          for (int e = 0; e < 4; ++e) { x[2 * e] = bf_lo(w0[e]); x[2 * e + 1] = bf_hi(w0[e]); x[8 + 2 * e] = bf_lo(w1[e]); x[8 + 2 * e + 1] = bf_hi(w1[e]); }
          float s = 0.f;
#pragma unroll
          for (int e = 0; e < 16; ++e) s += x[e];
          const float mean = wave_sum(s) * (1.0f / 1024.0f); float q = 0.f;
#pragma unroll
          for (int e = 0; e < 16; ++e) { x[e] -= mean; q += x[e] * x[e]; }
          const float rstd = 1.0f / sqrtf(wave_sum(q) * (1.0f / 1024.0f) + LN_EPS);
#pragma unroll
          for (int e = 0; e < 16; ++e) x[e] = x[e] * rstd * G[e >> 2][e & 3] + Bv[e >> 2][e & 3];
          u32x4 o0, o1;
#pragma unroll
          for (int e = 0; e < 4; ++e) { o0[e] = pk2(x[2 * e], x[2 * e + 1]); o1[e] = pk2(x[8 + 2 * e], x[8 + 2 * e + 1]); }
          vp[0] = o0; vp[1] = o1; }
        { const float pos = (float)(row & (SEQ - 1)); float cs[8], sn[8];
#pragma unroll
          for (int e = 0; e < 8; ++e) { const float ang = pos * invf[e]; const double rev = (double)ang * 0.15915494309189535; const float fr = (float)(rev - rint(rev));
              cs[e] = __builtin_amdgcn_cosf(fr); sn[e] = __builtin_amdgcn_sinf(fr); }
#pragma unroll
          for (int which = 0; which < 2; ++which) { bf16_t* base = pr + 2048 + which * 1024 + comp * 64 + 8 * sub; const float scl = which == 0 ? QSCALE : 1.0f;
              const u32x4 a = *(const u32x4*)base, bq = *(const u32x4*)(base + 32); u32x4 o1, o2;
#pragma unroll
              for (int e = 0; e < 4; ++e) { const float x1l = bf_lo(a[e]), x1h = bf_hi(a[e]), x2l = bf_lo(bq[e]), x2h = bf_hi(bq[e]);
                  o1[e] = pk2((x1l * cs[2 * e] - x2l * sn[2 * e]) * scl, (x1h * cs[2 * e + 1] - x2h * sn[2 * e + 1]) * scl);
                  o2[e] = pk2((x2l * cs[2 * e] + x1l * sn[2 * e]) * scl, (x2h * cs[2 * e + 1] + x1h * sn[2 * e + 1]) * scl); }
              *(u32x4*)base = o1; *(u32x4*)(base + 32) = o2; } }
    }
}

__device__ __forceinline__ void gmlp_unit(int unit, const bf16_t* PROJ, const float* ws_, const float* bs_, bf16_t* MIX, LAS unsigned char* lds, int tid, int lane, int wave) {
    const int g = unit & 7, tb = unit >> 3; const size_t t0 = (size_t)tb * 128;
    LAS bf16_t* TT = (LAS bf16_t*)lds;
#pragma unroll
    for (int i = 0; i < 4; ++i) { const int p = tid + 512 * i, j = p >> 4, ch = p & 15;
        const u32x4 v = *(const u32x4*)(PROJ + (t0 + j) * PROJW + 1024 + g * 128 + ch * 8);
#pragma unroll
        for (int e = 0; e < 4; ++e) { TT[(ch * 8 + 2 * e) * 136 + j] = (bf16_t)(v[e] & 0xffffu); TT[(ch * 8 + 2 * e + 1) * 136 + j] = (bf16_t)(v[e] >> 16); } }
    __syncthreads();
    const int iq = wave & 3, chh = wave >> 2, r32 = lane & 31, hi = lane >> 5;
    const int ns = iq < 2 ? 4 : 8;
    f32x16 acc[2]; acc[0] = f32x16{}; acc[1] = f32x16{};
    const float* wrow = ws_ + ((size_t)g * 128 + 32 * iq + r32) * 128 + 8 * hi;
    for (int s = 0; s < ns; ++s) {
        const f32x4 w0 = *(const f32x4*)(wrow + 16 * s), w1 = *(const f32x4*)(wrow + 16 * s + 4);
        u32x4 wb; wb.x = pk2(w0[0], w0[1]); wb.y = pk2(w0[2], w0[3]); wb.z = pk2(w1[0], w1[1]); wb.w = pk2(w1[2], w1[3]);
        const bf16x8 bfr = __builtin_bit_cast(bf16x8, wb);
#pragma unroll
        for (int blk = 0; blk < 2; ++blk) { const bf16x8 afr = *(const LAS bf16x8*)(TT + (64 * chh + 32 * blk + r32) * 136 + 16 * s + 8 * hi);
            acc[blk] = __builtin_amdgcn_mfma_f32_32x32x16_bf16(afr, bfr, acc[blk], 0, 0, 0); }
    }
    const int i = 32 * iq + r32; const float bsv = bs_[g * 128 + i];
    const bf16_t* up = PROJ + (t0 + i) * PROJW + g * 128; bf16_t* op = MIX + (t0 + i) * DM + g * 128;
#pragma unroll
    for (int blk = 0; blk < 2; ++blk)
#pragma unroll
        for (int q = 0; q < 4; ++q) { const int c = 64 * chh + 32 * blk + 8 * q + 4 * hi; const u32x2 uu = *(const u32x2*)(up + c);
            u32x2 o; o.x = pk2(bf_lo(uu.x) * (acc[blk][4 * q] + bsv), bf_hi(uu.x) * (acc[blk][4 * q + 1] + bsv)); o.y = pk2(bf_lo(uu.y) * (acc[blk][4 * q + 2] + bsv), bf_hi(uu.y) * (acc[blk][4 * q + 3] + bsv));
            *(u32x2*)(op + c) = o; }
    __syncthreads();
}

#define XB_TMO      128
#define XB_XCNT(j)  (256  + 64 * (j))
#define XB_XSUB(j)  (1280 + 64 * (j))
#define XB_XGEN(j)  (2304 + 64 * (j))
#define XB_TOP      3328
#define XB_TOPGEN   3392
#define XCD_BAR_WORDS 3456
#define XB_SPIN_CAP (1u << 18)

__device__ __forceinline__ unsigned xb_ld(unsigned* p)              { return __hip_atomic_load(p, __ATOMIC_RELAXED, __HIP_MEMORY_SCOPE_AGENT); }
__device__ __forceinline__ unsigned xb_add(unsigned* p, unsigned v) { return __hip_atomic_fetch_add(p, v, __ATOMIC_RELAXED, __HIP_MEMORY_SCOPE_AGENT); }
__device__ __forceinline__ unsigned xb_xcc_id() { return (unsigned)__builtin_amdgcn_s_getreg((3 << 11) | 20) & 0xFu; }
#define XB_SPIN(cond, bar) do { unsigned _sp = 0; while (cond) { __builtin_amdgcn_s_sleep(1); \
    if ((++_sp & 255u) == 0u) { if (xb_ld(&(bar)[XB_TMO])) break; if (_sp > XB_SPIN_CAP) { atomicAdd(&(bar)[XB_TMO], 1u); break; } } } } while (0)

struct XcdBarrier {
    unsigned* bar; unsigned x;
    volatile LAS unsigned* st;
};

__device__ __forceinline__ XcdBarrier xcd_barrier_post(unsigned* bar, volatile LAS unsigned* st) {
    XcdBarrier b; b.bar = bar; b.x = xb_xcc_id(); b.st = st;
    if (threadIdx.x == 0) (void)xb_add(&bar[XB_XCNT(b.x)], 1u);
    return b;
}
__device__ __forceinline__ void xcd_barrier_complete(unsigned* bar, unsigned x, unsigned& nloc, unsigned& nx) {
    const unsigned G = gridDim.x * gridDim.y * gridDim.z;
    unsigned sum, cnt, mine, sp = 0u;
    for (;;) {
        sum = 0u; cnt = 0u; mine = 0u;
#pragma unroll
        for (unsigned j = 0; j < 16; ++j) { const unsigned c = xb_ld(&bar[XB_XCNT(j)]); sum += c; cnt += (c > 0u) ? 1u : 0u; mine = (j == x) ? c : mine; }
        if (sum == G) break;
        __builtin_amdgcn_s_sleep(1);
        if ((++sp & 255u) == 0u) { if (xb_ld(&bar[XB_TMO])) break; if (sp > XB_SPIN_CAP) { atomicAdd(&bar[XB_TMO], 1u); break; } }
    }
    nloc = mine > 0u ? mine : 1u; nx = cnt > 0u ? cnt : 1u;
}

__device__ __forceinline__ void xcd_barrier(const XcdBarrier& b) {
    asm volatile("s_waitcnt vmcnt(0)" ::: "memory");
    __syncthreads();
    if (threadIdx.x == 0) {
        unsigned* bar = b.bar;
        __builtin_amdgcn_s_waitcnt(0);
        unsigned nloc = b.st[0], nx = b.st[1];
        if (nloc == 0u) { xcd_barrier_complete(bar, b.x, nloc, nx); b.st[0] = nloc; b.st[1] = nx; }
        const unsigned old = xb_add(&bar[XB_XSUB(b.x)], 1u);
        const unsigned gen = old / nloc;
        if (old + 1u == (gen + 1u) * nloc) {
            __builtin_amdgcn_fence(__ATOMIC_RELEASE, "agent");
            asm volatile("s_waitcnt vmcnt(0)" ::: "memory");
            const unsigned og = xb_add(&bar[XB_TOP], 1u);
            const unsigned tg = og / nx;
            if (og + 1u == (tg + 1u) * nx) xb_add(&bar[XB_TOPGEN], 1u);
            else XB_SPIN(xb_ld(&bar[XB_TOPGEN]) == tg, bar);
            __builtin_amdgcn_fence(__ATOMIC_ACQUIRE, "agent");
            xb_add(&bar[XB_XGEN(b.x)], 1u);
            asm volatile("s_waitcnt vmcnt(0)" ::: "memory");
        } else {
            XB_SPIN(xb_ld(&bar[XB_XGEN(b.x)]) == gen, bar);
            __builtin_amdgcn_fence(__ATOMIC_ACQUIRE, "agent");
            asm volatile("s_waitcnt vmcnt(0)" ::: "memory");
        }
    }
    __syncthreads();
}
#define ATT_THR 8.0f
#ifndef ATT_DMA_REP
#define ATT_DMA_REP 1
#endif
#define MAXF(a, b) __builtin_amdgcn_fmed3f((a), (b), __builtin_inff())
#define MFMA32(a, b, c) __builtin_amdgcn_mfma_f32_32x32x16_bf16((a), (b), (c), 0, 0, 0)
__device__ __forceinline__ float att_rowmax(const f32x16& p0, const f32x16& p1) {
    float a = MAXF(p0[0], p1[0]), b = MAXF(p0[1], p1[1]);
#pragma unroll
    for (int r = 2; r < 16; r += 2) { a = MAXF(MAXF(a, p0[r]), p1[r]); b = MAXF(MAXF(b, p0[r + 1]), p1[r + 1]); }
    a = MAXF(a, b);
    auto rr = __builtin_amdgcn_permlane32_swap(__float_as_uint(a), __float_as_uint(a), false, false);
    return MAXF(__uint_as_float(rr[0]), __uint_as_float(rr[1]));
}
__device__ __forceinline__ void attn_unit(int b, int h, int qb, const bf16_t* PROJ, const bf16_t* VT, bf16_t* MIX, float lam, const float* subg, LAS unsigned char* lds, int tid, int lane, int wave) {
    const int r32 = lane & 31, hi = lane >> 5, comp = wave >> 2, wq = wave & 3;
    const size_t tok0 = (size_t)b * SEQ + 128 * qb;
    bf16x8 qr[4];
    { const bf16_t* qp = PROJ + (tok0 + 32 * wq + r32) * PROJW + 2048 + h * 128 + comp * 64 + 8 * hi;
#pragma unroll
      for (int d0 = 0; d0 < 4; ++d0) qr[d0] = *(const bf16x8*)(qp + 16 * d0); }
    const int NT = 2 * qb + 2, my_nt = wq < 2 ? NT - 1 : NT;
    const bf16_t* gK0; const bf16_t* gV0;
    { const int krow = (tid >> 3) & 63, sw = tid & 7, chunk = sw ^ ((krow >> 1) & 7); gK0 = PROJ + ((size_t)b * SEQ + krow) * PROJW + 3072 + h * 128 + chunk * 8;
      gV0 = VT + (size_t)(h * 128 + krow) * MTOK + (size_t)b * SEQ + chunk * 8; }
    const int pr = (r32 & 19) | ((r32 & 4) << 1) | ((r32 & 8) >> 1);
    int koff[4], voff[4];
#pragma unroll
    for (int d0 = 0; d0 < 4; ++d0) { koff[d0] = comp * 8192 + pr * 128 + (((2 * d0 + hi) ^ ((pr >> 1) & 7)) << 4); voff[d0] = r32 * 128 + (((2 * d0 + hi) ^ ((r32 >> 1) & 7)) << 4); }
    f32x16 o[4]; o[0] = f32x16{}; o[1] = f32x16{}; o[2] = f32x16{}; o[3] = f32x16{};
    f32x16 negm = f32x16{};
    float l_run = 0.f;
    u32x4 pw[4];
#define ATT_DMA(t) do { LAS unsigned char* ks_ = lds + ((t) % 3) * 16384 + wave * 1024; LAS unsigned char* vs_ = lds + 49152 + ((t) & 3) * 16384 + wave * 1024; \
        _Pragma("unroll") for (int i_ = 0; i_ < 2 * ATT_DMA_REP; ++i_) { const int i = i_ & 1; \
            __builtin_amdgcn_global_load_lds((const unsigned*)(gK0 + (size_t)(t) * 64 * PROJW + i * 64), (LAS unsigned*)(ks_ + i * 8192), 16, 0, 0); \
            __builtin_amdgcn_global_load_lds((const unsigned*)(gV0 + (size_t)(t) * 64 + (size_t)i * 64 * MTOK), (LAS unsigned*)(vs_ + i * 8192), 16, 0, 0); } } while (0)
#define ATT_STAGE(t) do { if ((t) + 1 < NT) { if (ATT_DMA_REP == 1) asm volatile("s_waitcnt vmcnt(4)" ::: "memory"); else asm volatile("s_waitcnt vmcnt(8)" ::: "memory"); } else asm volatile("s_waitcnt vmcnt(0)" ::: "memory"); \
        __builtin_amdgcn_s_barrier(); asm volatile("" ::: "memory"); if ((t) + 2 < NT) ATT_DMA((t) + 2); } while (0)
#define ATT_LDK(KF, KST) do { _Pragma("unroll") for (int d0 = 0; d0 < 4; ++d0) { KF[2 * d0] = *(const LAS bf16x8*)((KST) + koff[d0]); KF[2 * d0 + 1] = *(const LAS bf16x8*)((KST) + koff[d0] + 4096); } } while (0)
#define ATT_LDV(VF, VST, BLK) do { _Pragma("unroll") for (int s = 0; s < 4; ++s) VF[s] = *(const LAS bf16x8*)((VST) + voff[s] + (BLK) * 4096); } while (0)
#define ATT_QK(P0, P1, KF) do { P0 = MFMA32(KF[0], qr[0], negm); P1 = MFMA32(KF[1], qr[0], negm); \
        _Pragma("unroll") for (int d0 = 1; d0 < 4; ++d0) { P0 = MFMA32(KF[2 * d0], qr[d0], P0); P1 = MFMA32(KF[2 * d0 + 1], qr[d0], P1); } } while (0)
#define ATT_PV(VF, BLK) do { _Pragma("unroll") for (int s = 0; s < 4; ++s) o[BLK] = MFMA32(VF[s], __builtin_bit_cast(bf16x8, pw[s]), o[BLK]); } while (0)
#define ATT_EXP_PACK(P0, P1, PW) do { float ls0 = 0.f, ls1 = 0.f; \
        _Pragma("unroll") for (int r = 0; r < 16; ++r) { P0[r] = __builtin_amdgcn_exp2f(P0[r]); P1[r] = __builtin_amdgcn_exp2f(P1[r]); } \
        _Pragma("unroll") for (int r = 0; r < 16; r += 2) { ls0 += P0[r] + P1[r]; ls1 += P0[r + 1] + P1[r + 1]; } \
        l_run += ls0 + ls1; \
        PW[0] = (u32x4){pk2(P0[0], P0[1]), pk2(P0[2], P0[3]), pk2(P0[4], P0[5]), pk2(P0[6], P0[7])}; PW[1] = (u32x4){pk2(P0[8], P0[9]), pk2(P0[10], P0[11]), pk2(P0[12], P0[13]), pk2(P0[14], P0[15])}; \
        PW[2] = (u32x4){pk2(P1[0], P1[1]), pk2(P1[2], P1[3]), pk2(P1[4], P1[5]), pk2(P1[6], P1[7])}; PW[3] = (u32x4){pk2(P1[8], P1[9]), pk2(P1[10], P1[11]), pk2(P1[12], P1[13]), pk2(P1[14], P1[15])}; } while (0)
    ATT_DMA(0); ATT_DMA(1);
    ATT_STAGE(0);
    {
        bf16x8 kf[8]; ATT_LDK(kf, lds);
        f32x16 p0, p1; ATT_QK(p0, p1, kf);
        const float rm = att_rowmax(p0, p1);
#pragma unroll
        for (int r = 0; r < 16; ++r) { p0[r] -= rm; p1[r] -= rm; negm[r] = -rm; }
        ATT_EXP_PACK(p0, p1, pw);
    }
    for (int t = 1; t < my_nt; ++t) {
        ATT_STAGE(t);
        const LAS unsigned char* kst = lds + (t % 3) * 16384;
        const LAS unsigned char* vpr = lds + 49152 + ((t - 1) & 3) * 16384;
        bf16x8 kf[8], v0[4], v1[4], v2[4], v3[4];
        ATT_LDK(kf, kst); ATT_LDV(v0, vpr, 0);
        __builtin_amdgcn_sched_barrier(0);
        f32x16 p0, p1; ATT_QK(p0, p1, kf);
        __builtin_amdgcn_sched_barrier(0);
        ATT_LDV(v1, vpr, 1); ATT_LDV(v2, vpr, 2);
        ATT_PV(v0, 0); ATT_PV(v1, 1);
        __builtin_amdgcn_sched_barrier(0);
        ATT_LDV(v3, vpr, 3);
        const float rm = att_rowmax(p0, p1);
        float fsc = 1.f; const bool resc = __any(rm > ATT_THR);
        if (__builtin_expect(resc, 0)) { const float dl = fmaxf(rm, 0.f); fsc = __builtin_amdgcn_exp2f(-dl); l_run *= fsc;
#pragma unroll
            for (int r = 0; r < 16; ++r) { p0[r] -= dl; p1[r] -= dl; negm[r] -= dl; } }
        ATT_PV(v2, 2); ATT_PV(v3, 3);
        ATT_EXP_PACK(p0, p1, pw);
        if (__builtin_expect(resc, 0)) {
#pragma unroll
            for (int blk = 0; blk < 4; ++blk)
#pragma unroll
                for (int r = 0; r < 16; ++r) o[blk][r] *= fsc; }
    }
    if (my_nt < NT) ATT_STAGE(NT - 1);
    { const LAS unsigned char* vpr = lds + 49152 + ((my_nt - 1) & 3) * 16384; bf16x8 v0[4], v1[4], v2[4], v3[4]; ATT_LDV(v0, vpr, 0); ATT_LDV(v1, vpr, 1); ATT_LDV(v2, vpr, 2); ATT_LDV(v3, vpr, 3); ATT_PV(v0, 0); ATT_PV(v1, 1); ATT_PV(v2, 2); ATT_PV(v3, 3); }
    const float l_tot = swap_add(l_run); float inv = 1.0f / l_tot; if (comp == 1) inv *= lam;
    LAS float* comb = (LAS float*)lds;
    __syncthreads();
    if (comp == 1) {
#pragma unroll
        for (int blk = 0; blk < 4; ++blk)
#pragma unroll
            for (int q = 0; q < 4; ++q) { f32x4 v = {o[blk][4 * q] * inv, o[blk][4 * q + 1] * inv, o[blk][4 * q + 2] * inv, o[blk][4 * q + 3] * inv};
                *(LAS f32x4*)(comb + (32 * wq + r32) * 132 + 32 * blk + 8 * q + 4 * hi) = v; }
    }
    __syncthreads();
    if (comp == 0) {
        float ss = 0.f;
#pragma unroll
        for (int blk = 0; blk < 4; ++blk)
#pragma unroll
            for (int q = 0; q < 4; ++q) { const f32x4 c = *(const LAS f32x4*)(comb + (32 * wq + r32) * 132 + 32 * blk + 8 * q + 4 * hi);
#pragma unroll
                for (int e = 0; e < 4; ++e) { const float d = o[blk][4 * q + e] * inv - c[e]; o[blk][4 * q + e] = d; ss += d * d; } }
        ss = swap_add(ss);
        const float rn = (1.0f - LAM_INIT) / sqrtf(ss * (1.0f / 128.0f) + LN_EPS);
        bf16_t* op = MIX + (tok0 + 32 * wq + r32) * DM + 1024 + h * 128;
#pragma unroll
        for (int blk = 0; blk < 4; ++blk)
#pragma unroll
            for (int q = 0; q < 4; ++q) { const int dv = 32 * blk + 8 * q + 4 * hi; const f32x4 sg = *(const f32x4*)(subg + dv);
                u32x2 w; w.x = pk2(o[blk][4 * q] * rn * sg[0], o[blk][4 * q + 1] * rn * sg[1]); w.y = pk2(o[blk][4 * q + 2] * rn * sg[2], o[blk][4 * q + 3] * rn * sg[3]);
                *(u32x2*)(op + dv) = w; }
    }
    __syncthreads();
#undef ATT_STAGE
#undef ATT_DMA
#undef ATT_QK
#undef ATT_PV
#undef ATT_LDK
#undef ATT_LDV
#undef ATT_EXP_PACK
}
#ifndef REP_P0
#define REP_P0 1
#endif
#ifndef REP_P1
#define REP_P1 1
#endif
#ifndef REP_P2
#define REP_P2 1
#endif
#ifndef REP_P3
#define REP_P3 1
#endif
#ifndef REP_P5
#define REP_P5 1
#endif
#ifndef REP_P7A
#define REP_P7A 1
#endif
#ifndef REP_P7G
#define REP_P7G 1
#endif
#ifndef EXTRA_SYNCS
#define EXTRA_SYNCS 0
#endif
#define GEMM_MULTI(EPI, g, E) do { int bx_ = blockIdx.x; asm volatile("" : "+s"(bx_)); pg8::StaticOrder S_; S_.init((g).M, (g).N, (int)gridDim.x, bx_); pg8::gemm_phase<EPI, pg8::StaticOrder, true, true>(lds3, g, S_, E); } while (0)

__global__ void __launch_bounds__(NWAVES * 64, 2) fwd_megakernel(Args args) {
    extern __shared__ __attribute__((aligned(16))) unsigned char lds[];
    cg::grid_group grid = cg::this_grid();
    LAS unsigned char* lds3 = (LAS unsigned char*)lds;
    volatile LAS unsigned* xst = (volatile LAS unsigned*)(lds3 + LDS_BYTES - 64);
    if (threadIdx.x < 2) xst[threadIdx.x] = 0u;
    __syncthreads();
    const XcdBarrier xbar = xcd_barrier_post((unsigned*)(args.ws + WS_CTL), xst);
#define GRID_BAR() xcd_barrier(xbar)
#define PHASE_IDS() int tid = threadIdx.x; asm volatile("" : "+v"(tid)); const int lane = tid & 63, wave = __builtin_amdgcn_readfirstlane(tid >> 6); (void)lane; (void)wave
    unsigned char* ws = args.ws;
    float* mod = (float*)(ws + WS_MOD);
    bf16_t* H = (bf16_t*)(ws + WS_H); bf16_t* HID = (bf16_t*)(ws + WS_HID); bf16_t* PROJ = (bf16_t*)(ws + WS_PROJ); bf16_t* VT = (bf16_t*)(ws + WS_VT); bf16_t* MIX = (bf16_t*)(ws + WS_MIX);
    float* out = args.out; const float* x = args.in[0];

    for (int rep_ = 0; rep_ < REP_P0; ++rep_) { PHASE_IDS(); p0_prologue(args, lds3, tid, lane, wave); }
    for (int rep_ = 0; rep_ < EXTRA_SYNCS; ++rep_) GRID_BAR();
    grid.sync();
    for (int rep_ = 0; rep_ < REP_P1; ++rep_) { PHASE_IDS(); row_pass<0>(x, nullptr, H, nullptr, nullptr, mod + 0 * DM, mod + 1 * DM, lane, wave); }
    GRID_BAR();
    for (int rep_ = 0; rep_ < REP_P2; ++rep_) { pg8::Gemm g{H, (const bf16_t*)(ws + WS_WGU1), MTOK, 2 * DFF, DM}; pg8::EpiSwiglu E{HID, DFF}; GEMM_MULTI(pg8::EpiSwiglu, g, E); }
    GRID_BAR();
    for (int rep_ = 0; rep_ < REP_P3; ++rep_) { pg8::Gemm g{HID, (const bf16_t*)(ws + WS_WD1), MTOK, DM, DFF}; pg8::EpiResid E{x, out, mod + 2 * DM, ALPHA, 0.5f}; GEMM_MULTI(pg8::EpiResid, g, E); }
    GRID_BAR();
    { PHASE_IDS(); row_pass<1>(out, out, H, args.in[6], args.in[7], mod + 3 * DM, mod + 4 * DM, lane, wave); }
    GRID_BAR();
    for (int rep_ = 0; rep_ < REP_P5; ++rep_) {
    { pg8::Gemm g{H, (const bf16_t*)(ws + WS_WIN), MTOK, PROJW, DM}; pg8::EpiProj E{PROJ, PROJW, 8}; GEMM_MULTI(pg8::EpiProj, g, E); }
    { pg8::Gemm g{(const bf16_t*)(ws + WS_WIN) + (size_t)PROJW * DM, H, 1024, MTOK, DM}; pg8::EpiProj E{VT, MTOK, 0}; GEMM_MULTI(pg8::EpiProj, g, E); }
    }
    GRID_BAR();
    { PHASE_IDS(); proj_row_pass(PROJ, args.in[9], args.in[10], lane, wave); }
    GRID_BAR();
    {
        PHASE_IDS();
        const int bx = blockIdx.x, G = gridDim.x; const int vcu = (G % 8 == 0) ? (bx % 8) * (G / 8) + bx / 8 : bx;
        float lam;
        { const float a1 = lane < 64 ? args.in[13][lane] * args.in[14][lane] : 0.f, a2 = args.in[15][lane] * args.in[16][lane];
          lam = __expf(wave_sum(a1)) - __expf(wave_sum(a2)) + LAM_INIT; }
        for (int rep_ = 0; rep_ < REP_P7A; ++rep_)
        for (int P2 = 2 * vcu; P2 < 1024; P2 += (P2 & 1) ? 2 * G - 1 : 1) {
            const int P = P2 >> 1, bh = P >> 5, s = P & 31;
            attn_unit(bh >> 3, bh & 7, (P2 & 1) ? s : 63 - s, PROJ, VT, MIX, lam, args.in[17], lds3, tid, lane, wave);
        }
        for (int rep_ = 0; rep_ < REP_P7G; ++rep_)
        for (int u = vcu; u < 1024; u += G) gmlp_unit(u, PROJ, args.in[11], args.in[12], MIX, lds3, tid, lane, wave);
    }
    GRID_BAR();
    { pg8::Gemm g{MIX, (const bf16_t*)(ws + WS_WOUT), MTOK, DM, DM}; pg8::EpiResid E{out, out, mod + 5 * DM, ALPHA, 1.0f}; GEMM_MULTI(pg8::EpiResid, g, E); }
    GRID_BAR();
    { PHASE_IDS(); row_pass<1>(out, out, H, args.in[19], args.in[20], mod + 6 * DM, mod + 7 * DM, lane, wave); }
    GRID_BAR();
    { pg8::Gemm g{H, (const bf16_t*)(ws + WS_WGU2), MTOK, 2 * DFF, DM}; pg8::EpiSwiglu E{HID, DFF}; GEMM_MULTI(pg8::EpiSwiglu, g, E); }
    GRID_BAR();
    { pg8::Gemm g{HID, (const bf16_t*)(ws + WS_WD2), MTOK, DM, DFF}; pg8::EpiResid E{out, out, mod + 8 * DM, ALPHA, 0.5f}; GEMM_MULTI(pg8::EpiResid, g, E); }
    GRID_BAR();
    { PHASE_IDS(); row_pass<2>(out, out, nullptr, args.in[23], args.in[24], nullptr, nullptr, lane, wave); }
}

extern "C" void kernel_launch(void* const* d_in, const int* in_sizes, int n_in, void* d_out, int out_size, void* d_ws, size_t ws_size, hipStream_t stream) {
    static int grid = 0;
    if (grid == 0) {
        if (n_in != 25 || in_sizes[0] != MTOK * DM || out_size != MTOK * DM || ws_size < WS_END) { fprintf(stderr, "kernel_launch: unexpected shapes (n_in %d, in0 %d, out %d, ws %zu)\n", n_in, n_in > 0 ? in_sizes[0] : -1, out_size, ws_size); grid = -1; return; }
        int dev = 0, cus = 0, per_cu = 0;
        hipGetDevice(&dev); hipDeviceGetAttribute(&cus, hipDeviceAttributeMultiprocessorCount, dev);
        if (hipFuncSetAttribute((const void*)fwd_megakernel, hipFuncAttributeMaxDynamicSharedMemorySize, LDS_BYTES) != hipSuccess) { fprintf(stderr, "kernel_launch: hipFuncSetAttribute failed\n"); grid = -1; return; }
        hipOccupancyMaxActiveBlocksPerMultiprocessor(&per_cu, (const void*)fwd_megakernel, NWAVES * 64, LDS_BYTES);
        (void)hipGetLastError();
        if (per_cu < 1) per_cu = 1;
        grid = cus * 1;
    }
    if (grid < 0) return;
    if (hipMemsetAsync((char*)d_ws + WS_CTL, 0, CTL_BYTES, stream) != hipSuccess) { fprintf(stderr, "kernel_launch: hipMemsetAsync failed\n"); return; }
    Args a{};
    for (int i = 0; i < 25; ++i) a.in[i] = (const float*)d_in[i];
    a.out = (float*)d_out; a.ws = (unsigned char*)d_ws;
    void* kargs[] = {&a};
    hipError_t e = hipLaunchCooperativeKernel((const void*)fwd_megakernel, dim3(grid), dim3(NWAVES * 64), kargs, LDS_BYTES, stream);
    if (e != hipSuccess) fprintf(stderr, "cooperative launch failed: %s (grid %d)\n", hipGetErrorString(e), grid);
}
```

```cpp
#include <hip/hip_runtime.h>
#include <hip/hip_cooperative_groups.h>
#include <cstdio>
#include <cstdint>
namespace cg = cooperative_groups;

namespace pg8 {
#define PG8_LAS __attribute__((address_space(3)))
typedef unsigned short bf16_t;
typedef short bf16x8 __attribute__((ext_vector_type(8)));
typedef float f32x4 __attribute__((ext_vector_type(4)));
typedef unsigned u32x4 __attribute__((ext_vector_type(4)));
constexpr int BM = 256, BK = 64, HALF = 128, HTB = HALF * BK * 2  , STAGE_BYTES = 8 * HTB, NXCD = 8, WGM = 8;

__host__ __device__ __forceinline__ int lds_byte(int r, int c) { const int st = (r >> 4) * 2 + (c >> 5), rr = r & 15, cc = c & 31, ob = rr * 64 + cc * 2; return st * 1024 + (ob ^ (((ob >> 9) & 1) << 5)); }
__host__ __device__ __forceinline__ void stage_rc(int b, int& R, int& C) { const int st = b / 1024, sb = b % 1024, swz = sb ^ (((sb >> 9) & 1) << 5); R = (st >> 1) * 16 + swz / 64; C = (st & 1) * 32 + (swz % 64) / 2; }
__host__ __device__ __forceinline__ int perm32(int rho) { const int n = rho >> 4, i = rho & 15; return 8 * (i >> 2) + 4 * n + (i & 3); }

struct Unit { int pm, pn; };
struct Gemm { const bf16_t* A; const bf16_t* Bt; int M, N, K; };

struct StaticOrder {
    int nM, nN, nwg, G, c;
    __host__ __device__ void init(int M, int N, int G_, int c_) { nM = M / BM; nN = N / BM; nwg = nM * nN; G = G_; c = c_; }
    __host__ __device__ bool next(int i, Unit& u) const {
        const long L = (long)i * G + c; if (L >= nwg) return false;
        int wgid = (int)L; { const int q = nwg / NXCD, r = nwg % NXCD, xcd = wgid % NXCD, off = wgid / NXCD; wgid = (xcd < r ? xcd * (q + 1) : r * (q + 1) + (xcd - r) * q) + off; }
        const int nig = WGM * nN, gid = wgid / nig, fm = gid * WGM, gsz = (nM - fm) < WGM ? (nM - fm) : WGM;
        u.pm = fm + ((wgid % nig) % gsz); u.pn = (wgid % nig) / gsz; return true;
    }
    __device__ __forceinline__ void a_ready(const Unit&) const {}
    __device__ __forceinline__ void done(const Unit&) const {}
};

__device__ __forceinline__ unsigned cvt_pk_bf16(float lo, float hi) { unsigned r; asm volatile("v_cvt_pk_bf16_f32 %0, %1, %2" : "=v"(r) : "v"(lo), "v"(hi)); return r; }
typedef float f32x2 __attribute__((ext_vector_type(2)));
__device__ __forceinline__ f32x2 gelu_pk(f32x2 v) {
    const f32x2 av = __builtin_elementwise_abs(v), d = av * 0.2316418882f + 1.0f;
    f32x2 t; t.x = __builtin_amdgcn_rcpf(d.x); t.y = __builtin_amdgcn_rcpf(d.y);
    f32x2 q = t * 0.5307027145f + (-0.7265760135f); q = q * t + 0.7107068705f; q = q * t + (-0.142248368f); q = q * t + 0.127414796f; q = q * t;
    const f32x2 s = (v * v) * (-0.72134752044f);
    f32x2 e; e.x = __builtin_amdgcn_exp2f(s.x); e.y = __builtin_amdgcn_exp2f(s.y);
    const f32x2 m = v * (q * e), r = v - m;
    f32x2 o; o.x = v.x < 0.f ? m.x : r.x; o.y = v.y < 0.f ? m.y : r.y; return o;
}

template <int ACT  > struct EpiBf16 {
    static constexpr bool PERM = true, AFTER_DRAIN = false; static_assert(ACT == 0 || ACT == 1, "EpiBf16: ACT is 0 (none) or 1 (gelu_pk)");
    bf16_t* O; int ldc; const float* bias; int split_cols; size_t split_stride; float scale0;
    __device__ __forceinline__ void operator()(const f32x4 (&acc)[2][2][4][2], const Unit& u, int wr, int wc, int fr, int fq) const {
        const int row0 = u.pm * BM + wr * 64 + fr; int colt = u.pn * BM; bf16_t* base = O;
        float sc = 1.f; if (split_cols) { const int t = colt / split_cols; base += (size_t)t * split_stride; colt -= t * split_cols; if (t == 0) sc = scale0; }
        const int col0 = colt + wc * 32 + 8 * fq, bcol0 = u.pn * BM + wc * 32 + 8 * fq;
        f32x4 bv[2][2];
#pragma unroll
        for (int bj = 0; bj < 2; ++bj)
#pragma unroll
            for (int n = 0; n < 2; ++n) bv[bj][n] = bias ? *(const f32x4*)(bias + bcol0 + bj * HALF + 4 * n) : (f32x4){0.f, 0.f, 0.f, 0.f};
#pragma unroll
        for (int ai = 0; ai < 2; ++ai)
#pragma unroll
            for (int m = 0; m < 4; ++m) { bf16_t* rowp = base + (size_t)(row0 + ai * HALF + m * 16) * ldc + col0;
#pragma unroll
                for (int bj = 0; bj < 2; ++bj) { f32x4 v0 = acc[ai][bj][m][0] + bv[bj][0], v1 = acc[ai][bj][m][1] + bv[bj][1];
                    if (ACT == 1) { f32x2 a = gelu_pk((f32x2){v0[0], v0[1]}), b = gelu_pk((f32x2){v0[2], v0[3]}), c = gelu_pk((f32x2){v1[0], v1[1]}), d = gelu_pk((f32x2){v1[2], v1[3]});
                        v0 = (f32x4){a.x, a.y, b.x, b.y}; v1 = (f32x4){c.x, c.y, d.x, d.y}; }
                    v0 = v0 * sc; v1 = v1 * sc; u32x4 w; w.x = cvt_pk_bf16(v0[0], v0[1]); w.y = cvt_pk_bf16(v0[2], v0[3]); w.z = cvt_pk_bf16(v1[0], v1[1]); w.w = cvt_pk_bf16(v1[2], v1[3]);
                    *(u32x4*)(rowp + bj * HALF) = w; } }
    }
};

template <class Epi, class Sched, bool ALIGN_EPI = false, bool SP2 = false>
__device__ __forceinline__ void gemm_phase(PG8_LAS unsigned char* lds, const Gemm g, const Sched& S, const Epi& E) {
    int tid_l = threadIdx.x; asm volatile("" : "+v"(tid_l));
    const int tid = tid_l, wid = __builtin_amdgcn_readfirstlane(tid >> 6), lane = tid & 63, wr = wid >> 2, wc = wid & 3, fr = lane & 15, fq = lane >> 4;
    const int K = g.K, nt = K / BK;
    unsigned voffA[2], voffB[2];
#pragma unroll
    for (int i = 0; i < 2; ++i) { int R, C; stage_rc(tid * 16 + i * 8192, R, C); const int Rb = Epi::PERM ? ((R & ~31) + perm32(R & 31)) : R;
        voffA[i] = (unsigned)(R * K + C) * 2u; voffB[i] = (unsigned)(Rb * K + C) * 2u; }
    const size_t kstep = (size_t)(BK * 2);
    const size_t hstep = (size_t)HALF * K * 2;
    const size_t tstep = 2 * hstep;
    const unsigned ldsw = (unsigned)wid * 1024u;
    const int aoff = lds_byte(wr * 64 + fr, fq * 8), boff = lds_byte(wc * 32 + fr, fq * 8);
#define PG8_SA(b, h) (((b) * 2 + (h)) * HTB)
#define PG8_SB(b, h) ((4 + (b) * 2 + (h)) * HTB)
#define PG8_STAGE(bufoff, gbase, voff) do { _Pragma("unroll") for (int _i = 0; _i < 2; ++_i) \
        __builtin_amdgcn_global_load_lds((const unsigned*)((const char*)(gbase) + (voff)[_i]), (PG8_LAS unsigned*)(lds + (bufoff) + ldsw + _i * 8192), 16, 0, 0); } while (0)
#define PG8_LDA(dst, b, h) do { _Pragma("unroll") for (int m = 0; m < 4; ++m) _Pragma("unroll") for (int k = 0; k < 2; ++k) dst[m][k] = *(const PG8_LAS bf16x8*)(lds + PG8_SA(b, h) + aoff + m * 2048 + k * 1024); } while (0)
#define PG8_LDB(dst, b, h) do { _Pragma("unroll") for (int n = 0; n < 2; ++n) _Pragma("unroll") for (int k = 0; k < 2; ++k) dst[n][k] = *(const PG8_LAS bf16x8*)(lds + PG8_SB(b, h) + boff + n * 2048 + k * 1024); } while (0)
#define PG8_MMA(ai, bj, At, Bt) do { __builtin_amdgcn_s_setprio(1); _Pragma("unroll") for (int m = 0; m < 4; ++m) _Pragma("unroll") for (int n = 0; n < 2; ++n) _Pragma("unroll") for (int k = 0; k < 2; ++k) \
        acc[ai][bj][m][n] = __builtin_amdgcn_mfma_f32_16x16x32_bf16(Bt[n][k], At[m][k], acc[ai][bj][m][n], 0, 0, 0); __builtin_amdgcn_s_setprio(0); } while (0)
#define PG8_WAIT_V(n) asm volatile("s_waitcnt vmcnt(" #n ")" ::: "memory")
#define PG8_WAIT_L(n) asm volatile("s_waitcnt lgkmcnt(" #n ")" ::: "memory")
#define PG8_BAR __builtin_amdgcn_s_barrier()
#define PG8_SCHED __builtin_amdgcn_sched_barrier(0)
    Unit cur, nxt; int ui = 0;
    if (!S.next(0, cur)) return;
    f32x4 acc[2][2][4][2];
#pragma unroll
    for (int a = 0; a < 2; ++a)
#pragma unroll
        for (int b = 0; b < 2; ++b)
#pragma unroll
            for (int m = 0; m < 4; ++m)
#pragma unroll
                for (int n = 0; n < 2; ++n) acc[a][b][m][n] = (f32x4){0.f, 0.f, 0.f, 0.f};
    bf16x8 At[4][2], B0[2][2], B1[2][2];
    const char* cA = (const char*)g.A + (size_t)cur.pm * tstep; const char* cB = (const char*)g.Bt + (size_t)cur.pn * tstep;
    S.a_ready(cur);
    if constexpr (SP2) {
        PG8_STAGE(PG8_SB(0, 0), cB, voffB); PG8_STAGE(PG8_SB(0, 1), cB + hstep, voffB); PG8_STAGE(PG8_SA(0, 0), cA, voffA); PG8_STAGE(PG8_SA(0, 1), cA + hstep, voffA);
        if (wr == 1) PG8_BAR;
        PG8_WAIT_V(2); PG8_BAR;
        PG8_STAGE(PG8_SB(1, 0), cB + kstep, voffB); PG8_STAGE(PG8_SA(1, 0), cA + kstep, voffA); PG8_STAGE(PG8_SB(1, 1), cB + hstep + kstep, voffB);
        PG8_WAIT_V(6); PG8_BAR;
    } else {
        PG8_STAGE(PG8_SB(0, 0), cB, voffB); PG8_STAGE(PG8_SA(0, 0), cA, voffA); PG8_STAGE(PG8_SB(0, 1), cB + hstep, voffB); PG8_STAGE(PG8_SA(0, 1), cA + hstep, voffA);
        if (wr == 1) PG8_BAR;
        PG8_WAIT_V(4); PG8_BAR;
        PG8_STAGE(PG8_SB(1, 0), cB + kstep, voffB); PG8_STAGE(PG8_SA(1, 0), cA + kstep, voffA); PG8_STAGE(PG8_SB(1, 1), cB + hstep + kstep, voffB);
        PG8_WAIT_V(6); PG8_BAR;
    }
    for (;;) {
        const bool has_next = S.next(ui + 1, nxt);
        const char* nA = has_next ? (const char*)g.A + (size_t)nxt.pm * tstep : cA; const char* nB = has_next ? (const char*)g.Bt + (size_t)nxt.pn * tstep : cB;
        for (int t = 0; t < nt; t += 2) {
            const bool last = (t == nt - 2);
            const char* a1 = cA + (size_t)(t + 1) * kstep;
            const char* a2 = last ? nA : cA + (size_t)(t + 2) * kstep; const char* b2 = last ? nB : cB + (size_t)(t + 2) * kstep;
            const char* a3 = a2 + kstep; const char* b3 = b2 + kstep;
            if (last && has_next) S.a_ready(nxt);
            if constexpr (SP2) {
            PG8_LDB(B0, 0, 0); PG8_LDB(B1, 0, 1); PG8_SCHED; PG8_LDA(At, 0, 0); PG8_STAGE(PG8_SA(1, 1), a1 + hstep, voffA);
            PG8_WAIT_V(8); PG8_WAIT_L(0); PG8_BAR; PG8_MMA(0, 0, At, B0); PG8_MMA(0, 1, At, B1); PG8_BAR; PG8_SCHED;
            PG8_LDA(At, 0, 1); PG8_STAGE(PG8_SB(0, 0), b2, voffB); PG8_STAGE(PG8_SB(0, 1), b2 + hstep, voffB); PG8_STAGE(PG8_SA(0, 0), a2, voffA);
            PG8_WAIT_V(8); PG8_WAIT_L(0); PG8_BAR; PG8_MMA(1, 0, At, B0); PG8_MMA(1, 1, At, B1); PG8_BAR; PG8_SCHED;
            PG8_LDB(B0, 1, 0); PG8_LDB(B1, 1, 1); PG8_SCHED; PG8_LDA(At, 1, 0); PG8_STAGE(PG8_SA(0, 1), a2 + hstep, voffA);
            PG8_WAIT_V(8); PG8_WAIT_L(0); PG8_BAR; PG8_MMA(0, 0, At, B0); PG8_MMA(0, 1, At, B1); PG8_BAR; PG8_SCHED;
            PG8_LDA(At, 1, 1); PG8_STAGE(PG8_SB(1, 0), b3, voffB); PG8_STAGE(PG8_SB(1, 1), b3 + hstep, voffB); PG8_STAGE(PG8_SA(1, 0), a3, voffA);
            PG8_WAIT_V(8); PG8_WAIT_L(0); PG8_BAR; PG8_MMA(1, 0, At, B0); PG8_MMA(1, 1, At, B1); PG8_BAR; PG8_SCHED;
            } else {
            PG8_LDB(B0, 0, 0); PG8_SCHED; PG8_LDA(At, 0, 0); PG8_STAGE(PG8_SA(1, 1), a1 + hstep, voffA);
            PG8_WAIT_L(8); PG8_BAR; PG8_WAIT_L(0); PG8_MMA(0, 0, At, B0); PG8_BAR; PG8_SCHED;
            PG8_LDB(B1, 0, 1); PG8_STAGE(PG8_SB(0, 0), b2, voffB);
            PG8_BAR; PG8_WAIT_L(0); PG8_MMA(0, 1, At, B1); PG8_BAR;
            PG8_LDA(At, 0, 1); PG8_STAGE(PG8_SA(0, 0), a2, voffA);
            PG8_BAR; PG8_WAIT_L(0); PG8_MMA(1, 0, At, B0); PG8_BAR; PG8_SCHED;
            PG8_STAGE(PG8_SB(0, 1), b2 + hstep, voffB);
            PG8_WAIT_V(6); PG8_BAR; PG8_MMA(1, 1, At, B1); PG8_BAR;
            PG8_LDB(B0, 1, 0); PG8_SCHED; PG8_LDA(At, 1, 0); PG8_STAGE(PG8_SA(0, 1), a2 + hstep, voffA);
            PG8_WAIT_L(8); PG8_BAR; PG8_WAIT_L(0); PG8_MMA(0, 0, At, B0); PG8_BAR; PG8_SCHED;
            PG8_LDB(B1, 1, 1); PG8_STAGE(PG8_SB(1, 0), b3, voffB);
            PG8_BAR; PG8_WAIT_L(0); PG8_MMA(0, 1, At, B1); PG8_BAR;
            PG8_LDA(At, 1, 1); PG8_STAGE(PG8_SA(1, 0), a3, voffA);
            PG8_BAR; PG8_WAIT_L(0); PG8_MMA(1, 0, At, B0); PG8_BAR; PG8_SCHED;
            PG8_STAGE(PG8_SB(1, 1), b3 + hstep, voffB);
            PG8_WAIT_V(6); PG8_BAR; PG8_MMA(1, 1, At, B1); PG8_BAR;
            }
        }
        if constexpr (ALIGN_EPI) { if (wr == 0) PG8_BAR; }
        if constexpr (!Epi::AFTER_DRAIN) { E(acc, cur, wr, wc, fr, fq); S.done(cur); }
        if (!has_next) break;
#pragma unroll
        for (int a = 0; a < 2; ++a)
#pragma unroll
            for (int b = 0; b < 2; ++b)
#pragma unroll
                for (int m = 0; m < 4; ++m)
#pragma unroll
                    for (int n = 0; n < 2; ++n) acc[a][b][m][n] = (f32x4){0.f, 0.f, 0.f, 0.f};
        cur = nxt; cA = nA; cB = nB; ++ui;
        if constexpr (ALIGN_EPI) { if (wr == 1) PG8_BAR; }
    }
    PG8_WAIT_V(0);
    if constexpr (!ALIGN_EPI) { if (wr == 0) PG8_BAR; }
    PG8_BAR;
    if constexpr (Epi::AFTER_DRAIN) { E.fused(acc, cur, wr, wc, fr, fq, lds, wid, lane); S.done(cur); }
#undef PG8_SA
#undef PG8_SB
#undef PG8_STAGE
#undef PG8_LDA
#undef PG8_LDB
#undef PG8_MMA
#undef PG8_WAIT_V
#undef PG8_WAIT_L
#undef PG8_BAR
#undef PG8_SCHED
}
}

namespace pg8 {
__device__ __forceinline__ float silu_f(float g) { return g * __builtin_amdgcn_rcpf(1.0f + __builtin_amdgcn_exp2f(-1.4426950408889634f * g)); }
__device__ __forceinline__ float gelu_tanh_f(float v) { const float in = v * (1.0f + 0.044715f * v * v); return v * __builtin_amdgcn_rcpf(1.0f + __builtin_amdgcn_exp2f(-2.3022082f * in)); }

struct EpiSwiglu {
    static constexpr bool PERM = true, AFTER_DRAIN = false;
    bf16_t* O; int ldc;
    __device__ __forceinline__ void operator()(const f32x4 (&acc)[2][2][4][2], const Unit& u, int wr, int wc, int fr, int fq) const {
        const int row0 = u.pm * BM + wr * 64 + fr, col0 = u.pn * HALF + wc * 32 + 8 * fq;
#pragma unroll
        for (int ai = 0; ai < 2; ++ai)
#pragma unroll
            for (int m = 0; m < 4; ++m) { bf16_t* rowp = O + (size_t)(row0 + ai * HALF + m * 16) * ldc + col0;
                const f32x4 g0 = acc[ai][0][m][0], g1 = acc[ai][0][m][1], u0 = acc[ai][1][m][0], u1 = acc[ai][1][m][1];
                u32x4 w;
                w.x = cvt_pk_bf16(silu_f(g0[0]) * u0[0], silu_f(g0[1]) * u0[1]); w.y = cvt_pk_bf16(silu_f(g0[2]) * u0[2], silu_f(g0[3]) * u0[3]);
                w.z = cvt_pk_bf16(silu_f(g1[0]) * u1[0], silu_f(g1[1]) * u1[1]); w.w = cvt_pk_bf16(silu_f(g1[2]) * u1[2], silu_f(g1[3]) * u1[3]);
                *(u32x4*)rowp = w; }
    }
};
struct EpiResid {
    static constexpr bool PERM = false, AFTER_DRAIN = false;
    const float* xres; float* out; const float* gate; float alpha, coef;
    __device__ __forceinline__ void operator()(const f32x4 (&acc)[2][2][4][2], const Unit& u, int wr, int wc, int fr, int fq) const {
        const int row0 = u.pm * BM + wr * 64 + fr, col0 = u.pn * BM + wc * 32 + 4 * fq; const int b = u.pm >> 5;
#pragma unroll
        for (int bj = 0; bj < 2; ++bj)
#pragma unroll
            for (int n = 0; n < 2; ++n) { const f32x4 gv = (*(const f32x4*)(gate + (size_t)b * 18432 + col0 + bj * HALF + n * 16) + 1.0f) * coef;
#pragma unroll
                for (int ai = 0; ai < 2; ++ai)
#pragma unroll
                    for (int m = 0; m < 4; ++m) { const size_t off = (size_t)(row0 + ai * HALF + m * 16) * 2048 + col0 + bj * HALF + n * 16;
                        const f32x4 xr = *(const f32x4*)(xres + off); *(f32x4*)(out + off) = xr * alpha + gv * acc[ai][bj][m][n]; } }
    }
};
template <bool FIRST> struct EpiResidBf {
    static constexpr bool PERM = true, AFTER_DRAIN = false;
    const float* x0; const bf16_t* Tprev; const float* stats; const float* lng; const float* lnb; bf16_t* T; const float* gate; float alpha, coef;
    __device__ __forceinline__ void operator()(const f32x4 (&acc)[2][2][4][2], const Unit& u, int wr, int wc, int fr, int fq) const {
        const int row0 = u.pm * BM + wr * 64 + fr, col0 = u.pn * BM + wc * 32 + 8 * fq; const int b = u.pm >> 5;
#pragma unroll
        for (int bj = 0; bj < 2; ++bj) { const int col = col0 + bj * HALF;
            const f32x4 g0 = (*(const f32x4*)(gate + (size_t)b * 18432 + col) + 1.0f) * coef, g1 = (*(const f32x4*)(gate + (size_t)b * 18432 + col + 4) + 1.0f) * coef;
            f32x4 lg0 = {}, lg1 = {}, lb0 = {}, lb1 = {};
            if (!FIRST) { lg0 = *(const f32x4*)(lng + col); lg1 = *(const f32x4*)(lng + col + 4); lb0 = *(const f32x4*)(lnb + col); lb1 = *(const f32x4*)(lnb + col + 4); }
#pragma unroll
            for (int ai = 0; ai < 2; ++ai)
#pragma unroll
                for (int m = 0; m < 4; ++m) { const int row = row0 + ai * HALF + m * 16; const size_t off = (size_t)row * 2048 + col;
                    f32x4 x0v, x1v;
                    if (FIRST) { x0v = *(const f32x4*)(x0 + off); x1v = *(const f32x4*)(x0 + off + 4); }
                    else { const u32x4 t = *(const u32x4*)(Tprev + off); const float mean = stats[2 * row], rstd = stats[2 * row + 1];
                        x0v = (f32x4){__uint_as_float(t.x << 16), __uint_as_float(t.x & 0xffff0000u), __uint_as_float(t.y << 16), __uint_as_float(t.y & 0xffff0000u)};
                        x1v = (f32x4){__uint_as_float(t.z << 16), __uint_as_float(t.z & 0xffff0000u), __uint_as_float(t.w << 16), __uint_as_float(t.w & 0xffff0000u)};
                        x0v = (x0v - mean) * rstd * lg0 + lb0; x1v = (x1v - mean) * rstd * lg1 + lb1; }
                    const f32x4 o0 = x0v * alpha + g0 * acc[ai][bj][m][0], o1 = x1v * alpha + g1 * acc[ai][bj][m][1];
                    u32x4 w; w.x = cvt_pk_bf16(o0[0], o0[1]); w.y = cvt_pk_bf16(o0[2], o0[3]); w.z = cvt_pk_bf16(o1[0], o1[1]); w.w = cvt_pk_bf16(o1[2], o1[3]);
                    *(u32x4*)(T + off) = w; } }
    }
};
struct EpiProj {
    static constexpr bool PERM = true, AFTER_DRAIN = false;
    bf16_t* O; int ldc; int fused;
    const float* rope; float* part; float qscale;
    __device__ __forceinline__ void operator()(const f32x4 (&acc)[2][2][4][2], const Unit& u, int wr, int wc, int fr, int fq) const {
        const int row0 = u.pm * BM + wr * 64 + fr, col0 = u.pn * BM + wc * 32 + 8 * fq;
        const int mode = !fused ? 0 : (u.pn < 4 ? 1 : (u.pn < 8 ? 2 : 3));
        const float scl = (mode == 3 && u.pn < 12) ? qscale : 1.0f;
        const int f0 = 16 * (wc & 1) + 4 * fq;
#pragma unroll
        for (int ai = 0; ai < 2; ++ai)
#pragma unroll
            for (int m = 0; m < 4; ++m) { const int row = row0 + ai * HALF + m * 16; bf16_t* rowp = O + (size_t)row * ldc + col0;
                f32x4 cs0 = {}, cs1 = {};
                if (mode == 3) { const float* rp = rope + ((size_t)(row & 8191) * 32 + f0) * 2; cs0 = *(const f32x4*)rp; cs1 = *(const f32x4*)(rp + 4); }
                float s1 = 0.f, s2 = 0.f;
#pragma unroll
                for (int bj = 0; bj < 2; ++bj) { f32x4 v0 = acc[ai][bj][m][0], v1 = acc[ai][bj][m][1];
                    if (mode == 1 || mode == 2) {
#pragma unroll
                        for (int e = 0; e < 4; ++e) { v0[e] = gelu_tanh_f(v0[e]); v1[e] = gelu_tanh_f(v1[e]); }
                        if (mode == 2) {
#pragma unroll
                            for (int e = 0; e < 4; ++e) { s1 += v0[e] + v1[e]; s2 += v0[e] * v0[e] + v1[e] * v1[e]; } } }
                    else if (mode == 3) { const float c[4] = {cs0[0], cs0[2], cs1[0], cs1[2]}, sn[4] = {cs0[1], cs0[3], cs1[1], cs1[3]};
#pragma unroll
                        for (int e = 0; e < 4; ++e) { const float x1 = v0[e], x2 = v1[e]; v0[e] = (x1 * c[e] - x2 * sn[e]) * scl; v1[e] = (x2 * c[e] + x1 * sn[e]) * scl; } }
                    u32x4 w; w.x = cvt_pk_bf16(v0[0], v0[1]); w.y = cvt_pk_bf16(v0[2], v0[3]); w.z = cvt_pk_bf16(v1[0], v1[1]); w.w = cvt_pk_bf16(v1[2], v1[3]);
                    *(u32x4*)(rowp + bj * HALF) = w; }
                if (mode == 2) { s1 += __shfl_xor(s1, 16); s2 += __shfl_xor(s2, 16); s1 += __shfl_xor(s1, 32); s2 += __shfl_xor(s2, 32);
                    if (fq == 0) { typedef float f32x2v __attribute__((ext_vector_type(2))); *(f32x2v*)(part + ((size_t)row * 16 + (u.pn - 4) * 4 + wc) * 2) = (f32x2v){s1, s2}; } } }
    }
};
}

constexpr int BATCH = 2, SEQ = 8192, DM = 2048, MTOK = BATCH * SEQ, DFF = 5632, NMODW = 9 * DM;
constexpr int PROJW = 4096;
constexpr float LN_EPS = 1e-5f, ALPHA = 1.189207115002721f  ;
constexpr float QSCALE = 0.125f * 1.4426950408889634f;
constexpr float LAM_INIT = 0.2f;

constexpr size_t MiB = 1u << 20;
constexpr size_t WS_MOD = 0, WS_WGU1 = 1 * MiB, WS_WD1 = 45 * MiB, WS_WIN = 67 * MiB, WS_WOUT = 87 * MiB, WS_WGU2 = 95 * MiB, WS_WD2 = 139 * MiB;
constexpr size_t WS_H = 161 * MiB, WS_HID = 225 * MiB, WS_PROJ = WS_HID, WS_VT = WS_HID + 128 * MiB, WS_MIX = 401 * MiB, WS_END = 465 * MiB;
static_assert(WS_WGU1 + (size_t)2 * DFF * DM * 2 <= WS_WD1 && WS_WD1 + (size_t)DM * DFF * 2 <= WS_WIN && WS_WIN + (size_t)5120 * DM * 2 <= WS_WOUT && WS_WOUT + (size_t)DM * DM * 2 <= WS_WGU2, "ws map 1");
static_assert(WS_WGU2 + (size_t)2 * DFF * DM * 2 <= WS_WD2 && WS_WD2 + (size_t)DM * DFF * 2 <= WS_H && WS_H + (size_t)MTOK * DM * 2 <= WS_HID && WS_HID + (size_t)MTOK * DFF * 2 <= WS_MIX, "ws map 2");
static_assert(WS_PROJ + (size_t)MTOK * PROJW * 2 <= WS_VT && WS_VT + (size_t)1024 * MTOK * 2 <= WS_MIX && WS_MIX + (size_t)MTOK * DM * 2 <= WS_END, "ws map 3");

constexpr size_t WS_STATS = 640 * 1024;
constexpr size_t WS_T = WS_END, WS_ROPE = WS_END + 64 * MiB, WS_PART = WS_ROPE + 2 * MiB, WS_END2 = WS_PART + 2 * MiB;
constexpr size_t WS_T_unused_ = 0;
constexpr size_t WS_CTL = 512 * 1024, CTL_BYTES = 16384;
constexpr int NWAVES = 8, LDS_BYTES = 147456;

#define LAS __attribute__((address_space(3)))
typedef unsigned short bf16_t;
typedef short bf16x8 __attribute__((ext_vector_type(8)));
typedef float f32x4 __attribute__((ext_vector_type(4)));
typedef float f32x16 __attribute__((ext_vector_type(16)));
typedef unsigned u32x4 __attribute__((ext_vector_type(4)));
typedef unsigned u32x2 __attribute__((ext_vector_type(2)));
typedef float f32x2_t __attribute__((ext_vector_type(2))); typedef __bf16 bf16x2_t __attribute__((ext_vector_type(2)));
__device__ __forceinline__ unsigned pk2(float lo, float hi) { f32x2_t v = {lo, hi}; bf16x2_t b = __builtin_convertvector(v, bf16x2_t); return __builtin_bit_cast(unsigned, b); }
__device__ __forceinline__ float bf_lo(unsigned w) { return __uint_as_float(w << 16); }
__device__ __forceinline__ float bf_hi(unsigned w) { return __uint_as_float(w & 0xffff0000u); }
__device__ __forceinline__ float wave_sum(float v) {
#pragma unroll
    for (int o = 1; o < 64; o <<= 1) v += __shfl_xor(v, o);
    return v;
}
__device__ __forceinline__ float swap_add(float v) { auto rr = __builtin_amdgcn_permlane32_swap(__float_as_uint(v), __float_as_uint(v), false, false); return __uint_as_float(rr[0]) + __uint_as_float(rr[1]); }
__device__ __forceinline__ float swap_max(float v) { auto rr = __builtin_amdgcn_permlane32_swap(__float_as_uint(v), __float_as_uint(v), false, false); return fmaxf(__uint_as_float(rr[0]), __uint_as_float(rr[1])); }
#define LDS_WAIT() asm volatile("s_waitcnt lgkmcnt(0)" ::: "memory")

struct Args { const float* in[25]; float* out; unsigned char* ws; };

__device__ __forceinline__ void transpose_item64(const float* W, int K, int N, bf16_t* WT, int k0, int n0, int dest_row0, bool qkperm, LAS float* scr, int lane) {
    const int nq = lane & 15, kr = lane >> 4;
#pragma unroll 4
    for (int i = 0; i < 16; ++i) { const int kk = 4 * i + kr; const f32x4 v = *(const f32x4*)(W + (size_t)(k0 + kk) * N + n0 + 4 * nq);
        LAS float* s = scr + kk * 65 + 4 * nq; s[0] = v[0]; s[1] = v[1]; s[2] = v[2]; s[3] = v[3]; }
    LDS_WAIT(); asm volatile("" ::: "memory");
    const int c = lane & 7;
#pragma unroll
    for (int j = 0; j < 8; ++j) { const int n = (lane >> 3) + 8 * j; const LAS float* s = scr + (8 * c) * 65 + n;
        u32x4 o; o.x = pk2(s[0 * 65], s[1 * 65]); o.y = pk2(s[2 * 65], s[3 * 65]); o.z = pk2(s[4 * 65], s[5 * 65]); o.w = pk2(s[6 * 65], s[7 * 65]);
        const int nd = qkperm ? 8 * ((n & 31) >> 2) + 4 * (n >> 5) + (n & 3) : n;
        *(u32x4*)(WT + (size_t)(dest_row0 + nd) * K + k0 + 8 * c) = o; }
    LDS_WAIT(); asm volatile("" ::: "memory");
}
__device__ __forceinline__ int gu_dest_row(int n0) { return n0 < DFF ? 256 * (n0 >> 7) + (n0 & 127) : 256 * ((n0 - DFF) >> 7) + 128 + ((n0 - DFF) & 127); }

__device__ __forceinline__ void p0_prologue(const Args& a, LAS unsigned char* lds, int tid, int lane, int wave) {
    unsigned char* ws = a.ws;
    { float* rt = (float*)(ws + WS_ROPE); const int gt = blockIdx.x * (NWAVES * 64) + tid, NGT = gridDim.x * NWAVES * 64;
      for (int e = gt; e < SEQ * 32; e += NGT) { const int pos = e >> 5, f = e & 31; const float invf = (float)exp2(-(double)f * 0.41524101186092029);
          const float ang = (float)pos * invf; const double rev = (double)ang * 0.15915494309189535; const float fr = (float)(rev - rint(rev));
          typedef float f32x2v __attribute__((ext_vector_type(2))); *(f32x2v*)(rt + 2 * (size_t)e) = (f32x2v){__builtin_amdgcn_cosf(fr), __builtin_amdgcn_sinf(fr)}; } }
    {
        LAS float* scr = (LAS float*)(lds + wave * 16640);
        const int gw = blockIdx.x * NWAVES + wave, NGW = gridDim.x * NWAVES;
        constexpr int IT_GU = (DM / 64) * (2 * DFF / 64), IT_DN = (DFF / 64) * (DM / 64), IT_IN = (DM / 64) * (5120 / 64), IT_OUT = (DM / 64) * (DM / 64);
        constexpr int NITEMS = 2 * IT_GU + 2 * IT_DN + IT_IN + IT_OUT;
        for (int it = gw; it < NITEMS; it += NGW) {
            int r = it; const float* W; bf16_t* WT; int K, N, mode = 0;
            bool qk = false;
            if (r < IT_GU) { W = a.in[4]; WT = (bf16_t*)(ws + WS_WGU1); K = DM; N = 2 * DFF; mode = 1; }
            else if ((r -= IT_GU) < IT_GU) { W = a.in[21]; WT = (bf16_t*)(ws + WS_WGU2); K = DM; N = 2 * DFF; mode = 1; }
            else if ((r -= IT_GU) < IT_DN) { W = a.in[5]; WT = (bf16_t*)(ws + WS_WD1); K = DFF; N = DM; }
            else if ((r -= IT_DN) < IT_DN) { W = a.in[22]; WT = (bf16_t*)(ws + WS_WD2); K = DFF; N = DM; }
            else if ((r -= IT_DN) < IT_IN) { W = a.in[8]; WT = (bf16_t*)(ws + WS_WIN); K = DM; N = 5120; qk = true; }
            else { r -= IT_IN; W = a.in[18]; WT = (bf16_t*)(ws + WS_WOUT); K = DM; N = DM; }
            const int nblk = N / 64, kb = r / nblk, nb = r % nblk, n0 = 64 * nb;
            transpose_item64(W, K, N, WT, 64 * kb, n0, mode ? gu_dest_row(n0) : n0, qk && n0 >= 2048 && n0 < 4096, scr, lane);
        }
    }
    __syncthreads();
    if (gridDim.x == 256) {
        const float* c = a.in[1]; const float* wada = a.in[2]; const float* bada = a.in[3]; float* mod = (float*)(ws + WS_MOD);
        LAS float* red = (LAS float*)lds;
        const int n4 = tid % 18, kg = tid / 18, colbase = 72 * blockIdx.x;
        if (kg < 28) {
            f32x4 a0 = {0.f, 0.f, 0.f, 0.f}, a1 = {0.f, 0.f, 0.f, 0.f};
            const float* wp = wada + (size_t)kg * NMODW + colbase + 4 * n4;
#pragma unroll 1
            for (int i0 = 0; i0 < 72; i0 += 8) {
                f32x4 w[8];
#pragma unroll
                for (int j = 0; j < 8; ++j) w[j] = *(const f32x4*)(wp + (size_t)(i0 + j) * 28 * NMODW);
#pragma unroll
                for (int j = 0; j < 8; ++j) { const int k = kg + 28 * (i0 + j); a0 += w[j] * pg8::silu_f(c[k]); a1 += w[j] * pg8::silu_f(c[DM + k]); } }
            for (int k = kg + 28 * 72; k < DM; k += 28) { const f32x4 w = *(const f32x4*)(wada + (size_t)k * NMODW + colbase + 4 * n4);
                a0 += w * pg8::silu_f(c[k]); a1 += w * pg8::silu_f(c[DM + k]); }
#pragma unroll
            for (int e = 0; e < 4; ++e) { red[(kg * 2 + 0) * 72 + 4 * n4 + e] = a0[e]; red[(kg * 2 + 1) * 72 + 4 * n4 + e] = a1[e]; }
        }
        __syncthreads();
        if (tid < 144) { const int b = tid / 72, col = tid % 72; float s = 0.f;
            for (int g = 0; g < 28; ++g) s += red[(g * 2 + b) * 72 + col];
            mod[(size_t)b * NMODW + colbase + col] = s + bada[colbase + col]; }
        __syncthreads();
    }
}

template <int MODE> __device__ __forceinline__ void row_pass(const float* src, float* xout, bf16_t* hout, const float* lng, const float* lnb, const float* msh, const float* msc, int lane, int wave) {
    const int gw = blockIdx.x * NWAVES + wave, NGW = gridDim.x * NWAVES;
    for (int row = gw; row < MTOK; row += NGW) {
        const int b = row >> 13;
        const f32x4* xr = (const f32x4*)(src + (size_t)row * DM) + lane;
        f32x4 v[8];
#pragma unroll
        for (int j = 0; j < 8; ++j) v[j] = xr[64 * j];
        float mean = 0.f, rstd = 1.f;
        if (MODE >= 1) {
            float s = 0.f;
#pragma unroll
            for (int j = 0; j < 8; ++j) s += (v[j][0] + v[j][1]) + (v[j][2] + v[j][3]);
            mean = wave_sum(s) * (1.0f / DM); float q = 0.f;
#pragma unroll
            for (int j = 0; j < 8; ++j) { const f32x4 d = v[j] - mean; q += (d[0] * d[0] + d[1] * d[1]) + (d[2] * d[2] + d[3] * d[3]); }
            rstd = 1.0f / sqrtf(wave_sum(q) * (1.0f / DM) + LN_EPS);
        }
#pragma unroll
        for (int j = 0; j < 8; ++j) { const int c4 = lane + 64 * j; f32x4 y = v[j];
            if (MODE >= 1) { const f32x4 g = ((const f32x4*)lng)[c4], bb = ((const f32x4*)lnb)[c4]; y = (v[j] - mean) * rstd * g + bb; ((f32x4*)(xout + (size_t)row * DM))[c4] = y; }
            if (MODE != 2) { const f32x4 sc = ((const f32x4*)(msc + (size_t)b * NMODW))[c4], sh = ((const f32x4*)(msh + (size_t)b * NMODW))[c4]; const f32x4 hh = y * (sc + 1.0f) + sh;
                u32x2 w; w.x = pk2(hh[0], hh[1]); w.y = pk2(hh[2], hh[3]); ((u32x2*)(hout + (size_t)row * DM))[c4] = w; } }
    }
}

template <bool LAST> __device__ __forceinline__ void ln_pass(const bf16_t* T, float* stats, bf16_t* hout, float* fout, const float* lng, const float* lnb, const float* msh, const float* msc, int lane, int wave) {
    const int gw = blockIdx.x * NWAVES + wave, NGW = gridDim.x * NWAVES;
    for (int row = gw; row < MTOK; row += NGW) {
        const int b = row >> 13;
        const u32x4* tr = (const u32x4*)(T + (size_t)row * DM) + lane;
        u32x4 t[4];
#pragma unroll
        for (int j = 0; j < 4; ++j) t[j] = tr[64 * j];
        float v[4][8]; float s = 0.f;
#pragma unroll
        for (int j = 0; j < 4; ++j)
#pragma unroll
            for (int e = 0; e < 4; ++e) { v[j][2 * e] = bf_lo(t[j][e]); v[j][2 * e + 1] = bf_hi(t[j][e]); s += v[j][2 * e] + v[j][2 * e + 1]; }
        const float mean = wave_sum(s) * (1.0f / DM); float q = 0.f;
#pragma unroll
        for (int j = 0; j < 4; ++j)
#pragma unroll
            for (int e = 0; e < 8; ++e) { const float d = v[j][e] - mean; q += d * d; }
        const float rstd = 1.0f / sqrtf(wave_sum(q) * (1.0f / DM) + LN_EPS);
        if (!LAST && lane == 0) { stats[2 * row] = mean; stats[2 * row + 1] = rstd; }
#pragma unroll
        for (int j = 0; j < 4; ++j) { const int c8 = 64 * j + lane;
            float y[8];
#pragma unroll
            for (int hh = 0; hh < 2; ++hh) { const f32x4 g = ((const f32x4*)lng)[2 * c8 + hh], bb = ((const f32x4*)lnb)[2 * c8 + hh];
#pragma unroll
                for (int e = 0; e < 4; ++e) y[4 * hh + e] = (v[j][4 * hh + e] - mean) * rstd * g[e] + bb[e]; }
            if (LAST) { ((f32x4*)(fout + (size_t)row * DM))[2 * c8] = (f32x4){y[0], y[1], y[2], y[3]}; ((f32x4*)(fout + (size_t)row * DM))[2 * c8 + 1] = (f32x4){y[4], y[5], y[6], y[7]}; }
            else {
#pragma unroll
                for (int hh = 0; hh < 2; ++hh) { const f32x4 sc = ((const f32x4*)(msc + (size_t)b * NMODW))[2 * c8 + hh], sh = ((const f32x4*)(msh + (size_t)b * NMODW))[2 * c8 + hh];
#pragma unroll
                    for (int e = 0; e < 4; ++e) y[4 * hh + e] = y[4 * hh + e] * (sc[e] + 1.0f) + sh[e]; }
                u32x4 w; w.x = pk2(y[0], y[1]); w.y = pk2(y[2], y[3]); w.z = pk2(y[4], y[5]); w.w = pk2(y[6], y[7]);
                ((u32x4*)(hout + (size_t)row * DM))[c8] = w; } }
    }
}

__device__ __forceinline__ void proj_row_pass(bf16_t* PROJ, const float* lng, const float* lnb, int lane, int wave) {
    const int gw = blockIdx.x * NWAVES + wave, NGW = gridDim.x * NWAVES;
    const int sub = lane & 3, comp = lane >> 2;
    float invf[8];
#pragma unroll
    for (int e = 0; e < 8; ++e) invf[e] = (float)exp2(-(double)(8 * sub + e) * 0.41524101186092029);
    f32x4 G[4], Bv[4];
#pragma unroll
    for (int e = 0; e < 4; ++e) { G[e] = ((const f32x4*)lng)[4 * lane + e]; Bv[e] = ((const f32x4*)lnb)[4 * lane + e]; }
    for (int row = gw; row < MTOK; row += NGW) {
        bf16_t* pr = PROJ + (size_t)row * PROJW;
        { u32x4* vp = (u32x4*)(pr + 1024 + 16 * lane); const u32x4 w0 = vp[0], w1 = vp[1]; float x[16];
#pragma unroll
          for (int e = 0; e < 4; ++e) { x[2 * e] = bf_lo(w0[e]); x[2 * e + 1] = bf_hi(w0[e]); x[8 + 2 * e] = bf_lo(w1[e]); x[8 + 2 * e + 1] = bf_hi(w1[e]); }
          float s = 0.f;
#pragma unroll
          for (int e = 0; e < 16; ++e) s += x[e];
          const float mean = wave_sum(s) * (1.0f / 1024.0f); float q = 0.f;
#pragma unroll
          for (int e = 0; e < 16; ++e) { x[e] -= mean; q += x[e] * x[e]; }
          const float rstd = 1.0f / sqrtf(wave_sum(q) * (1.0f / 1024.0f) + LN_EPS);
#pragma unroll
          for (int e = 0; e < 16; ++e) x[e] = x[e] * rstd * G[e >> 2][e & 3] + Bv[e >> 2][e & 3];
          u32x4 o0, o1;
#pragma unroll
          for (int e = 0; e < 4; ++e) { o0[e] = pk2(x[2 * e], x[2 * e + 1]); o1[e] = pk2(x[8 + 2 * e], x[8 + 2 * e + 1]); }
          vp[0] = o0; vp[1] = o1; }
        { const float pos = (float)(row & (SEQ - 1)); float cs[8], sn[8];
#pragma unroll
          for (int e = 0; e < 8; ++e) { const float ang = pos * invf[e]; const double rev = (double)ang * 0.15915494309189535; const float fr = (float)(rev - rint(rev));
              cs[e] = __builtin_amdgcn_cosf(fr); sn[e] = __builtin_amdgcn_sinf(fr); }
#pragma unroll
          for (int which = 0; which < 2; ++which) { bf16_t* base = pr + 2048 + which * 1024 + comp * 64 + 8 * sub; const float scl = which == 0 ? QSCALE : 1.0f;
              const u32x4 a = *(const u32x4*)base, bq = *(const u32x4*)(base + 32); u32x4 o1, o2;
#pragma unroll
              for (int e = 0; e < 4; ++e) { const float x1l = bf_lo(a[e]), x1h = bf_hi(a[e]), x2l = bf_lo(bq[e]), x2h = bf_hi(bq[e]);
                  o1[e] = pk2((x1l * cs[2 * e] - x2l * sn[2 * e]) * scl, (x1h * cs[2 * e + 1] - x2h * sn[2 * e + 1]) * scl);
                  o2[e] = pk2((x2l * cs[2 * e] + x1l * sn[2 * e]) * scl, (x2h * cs[2 * e + 1] + x1h * sn[2 * e + 1]) * scl); }
              *(u32x4*)base = o1; *(u32x4*)(base + 32) = o2; } }
    }
}

__device__ __forceinline__ void gmlp_unit(int unit, const bf16_t* PROJ, const float* part, const float* lng, const float* lnb, const float* ws_, const float* bs_, bf16_t* MIX, LAS unsigned char* lds, int tid, int lane, int wave) {
    const int g = unit & 7, tb = unit >> 3; const size_t t0 = (size_t)tb * 128;
    LAS bf16_t* TT = (LAS bf16_t*)lds;
    LAS float* MU = (LAS float*)(lds + 34816); LAS float* RS = MU + 128;
#pragma unroll
    for (int i = 0; i < 4; ++i) { const int p = tid + 512 * i, j = p >> 4, ch = p & 15;
        const u32x4 v = *(const u32x4*)(PROJ + (t0 + j) * PROJW + 1024 + g * 128 + ch * 8);
#pragma unroll
        for (int e = 0; e < 4; ++e) { TT[(ch * 8 + 2 * e) * 136 + j] = (bf16_t)(v[e] & 0xffffu); TT[(ch * 8 + 2 * e + 1) * 136 + j] = (bf16_t)(v[e] >> 16); } }
    if (tid < 128) { const f32x4* pp = (const f32x4*)(part + (t0 + tid) * 32); float s1 = 0.f, s2 = 0.f;
#pragma unroll
        for (int e = 0; e < 8; ++e) { const f32x4 v = pp[e]; s1 += v[0] + v[2]; s2 += v[1] + v[3]; }
        const float mean = s1 * (1.0f / 1024.0f), var = fmaxf(s2 * (1.0f / 1024.0f) - mean * mean, 0.f);
        MU[tid] = mean; RS[tid] = 1.0f / sqrtf(var + LN_EPS); }
    __syncthreads();
    const int iq = wave & 3, chh = wave >> 2, r32 = lane & 31, hi = lane >> 5;
    const int ns = iq < 2 ? 4 : 8;
    f32x16 acc[2]; acc[0] = f32x16{}; acc[1] = f32x16{};
    float r1 = 0.f, r2 = 0.f;
    const float* wrow = ws_ + ((size_t)g * 128 + 32 * iq + r32) * 128 + 8 * hi;
    for (int s = 0; s < ns; ++s) {
        f32x4 w0 = *(const f32x4*)(wrow + 16 * s), w1 = *(const f32x4*)(wrow + 16 * s + 4);
        const f32x4 rs0 = *(const LAS f32x4*)(RS + 16 * s + 8 * hi), rs1 = *(const LAS f32x4*)(RS + 16 * s + 8 * hi + 4), mu0 = *(const LAS f32x4*)(MU + 16 * s + 8 * hi), mu1 = *(const LAS f32x4*)(MU + 16 * s + 8 * hi + 4);
        r2 += (w0[0] + w0[1]) + (w0[2] + w0[3]) + (w1[0] + w1[1]) + (w1[2] + w1[3]);
        w0 = w0 * rs0; w1 = w1 * rs1;
        r1 += (w0[0] * mu0[0] + w0[1] * mu0[1]) + (w0[2] * mu0[2] + w0[3] * mu0[3]) + (w1[0] * mu1[0] + w1[1] * mu1[1]) + (w1[2] * mu1[2] + w1[3] * mu1[3]);
        u32x4 wb; wb.x = pk2(w0[0], w0[1]); wb.y = pk2(w0[2], w0[3]); wb.z = pk2(w1[0], w1[1]); wb.w = pk2(w1[2], w1[3]);
        const bf16x8 bfr = __builtin_bit_cast(bf16x8, wb);
#pragma unroll
        for (int blk = 0; blk < 2; ++blk) { const bf16x8 afr = *(const LAS bf16x8*)(TT + (64 * chh + 32 * blk + r32) * 136 + 16 * s + 8 * hi);
            acc[blk] = __builtin_amdgcn_mfma_f32_32x32x16_bf16(afr, bfr, acc[blk], 0, 0, 0); }
    }
    r1 = swap_add(r1); r2 = swap_add(r2);
    const int i = 32 * iq + r32; const float bsv = bs_[g * 128 + i];
    const bf16_t* up = PROJ + (t0 + i) * PROJW + g * 128; bf16_t* op = MIX + (t0 + i) * DM + g * 128;
#pragma unroll
    for (int blk = 0; blk < 2; ++blk)
#pragma unroll
        for (int q = 0; q < 4; ++q) { const int c = 64 * chh + 32 * blk + 8 * q + 4 * hi; const u32x2 uu = *(const u32x2*)(up + c);
            const f32x4 G = *(const f32x4*)(lng + g * 128 + c), B = *(const f32x4*)(lnb + g * 128 + c);
            const float m0 = G[0] * (acc[blk][4 * q] - r1) + B[0] * r2 + bsv, m1 = G[1] * (acc[blk][4 * q + 1] - r1) + B[1] * r2 + bsv, m2 = G[2] * (acc[blk][4 * q + 2] - r1) + B[2] * r2 + bsv, m3 = G[3] * (acc[blk][4 * q + 3] - r1) + B[3] * r2 + bsv;
            u32x2 o; o.x = pk2(bf_lo(uu.x) * m0, bf_hi(uu.x) * m1); o.y = pk2(bf_lo(uu.y) * m2, bf_hi(uu.y) * m3);
            *(u32x2*)(op + c) = o; }
    __syncthreads();
}

#define XB_TMO      128
#define XB_XCNT(j)  (256  + 64 * (j))
#define XB_XSUB(j)  (1280 + 64 * (j))
#define XB_XGEN(j)  (2304 + 64 * (j))
#define XB_TOP      3328
#define XB_TOPGEN   3392
#define XCD_BAR_WORDS 3456
#define XB_SPIN_CAP (1u << 18)

__device__ __forceinline__ unsigned xb_ld(unsigned* p)              { return __hip_atomic_load(p, __ATOMIC_RELAXED, __HIP_MEMORY_SCOPE_AGENT); }
__device__ __forceinline__ unsigned xb_add(unsigned* p, unsigned v) { return __hip_atomic_fetch_add(p, v, __ATOMIC_RELAXED, __HIP_MEMORY_SCOPE_AGENT); }
__device__ __forceinline__ unsigned xb_xcc_id() { return (unsigned)__builtin_amdgcn_s_getreg((3 << 11) | 20) & 0xFu; }
#define XB_SPIN(cond, bar) do { unsigned _sp = 0; while (cond) { __builtin_amdgcn_s_sleep(1); \
    if ((++_sp & 255u) == 0u) { if (xb_ld(&(bar)[XB_TMO])) break; if (_sp > XB_SPIN_CAP) { atomicAdd(&(bar)[XB_TMO], 1u); break; } } } } while (0)

struct XcdBarrier {
    unsigned* bar; unsigned x;
    volatile LAS unsigned* st;
};

__device__ __forceinline__ XcdBarrier xcd_barrier_post(unsigned* bar, volatile LAS unsigned* st) {
    XcdBarrier b; b.bar = bar; b.x = xb_xcc_id(); b.st = st;
    if (threadIdx.x == 0) (void)xb_add(&bar[XB_XCNT(b.x)], 1u);
    return b;
}
__device__ __forceinline__ void xcd_barrier_complete(unsigned* bar, unsigned x, unsigned& nloc, unsigned& nx) {
    const unsigned G = gridDim.x * gridDim.y * gridDim.z;
    unsigned sum, cnt, mine, sp = 0u;
    for (;;) {
        sum = 0u; cnt = 0u; mine = 0u;
#pragma unroll
        for (unsigned j = 0; j < 16; ++j) { const unsigned c = xb_ld(&bar[XB_XCNT(j)]); sum += c; cnt += (c > 0u) ? 1u : 0u; mine = (j == x) ? c : mine; }
        if (sum == G) break;
        __builtin_amdgcn_s_sleep(1);
        if ((++sp & 255u) == 0u) { if (xb_ld(&bar[XB_TMO])) break; if (sp > XB_SPIN_CAP) { atomicAdd(&bar[XB_TMO], 1u); break; } }
    }
    nloc = mine > 0u ? mine : 1u; nx = cnt > 0u ? cnt : 1u;
}

__device__ __forceinline__ void xcd_barrier(const XcdBarrier& b) {
    asm volatile("s_waitcnt vmcnt(0)" ::: "memory");
    __syncthreads();
    if (threadIdx.x == 0) {
        unsigned* bar = b.bar;
        __builtin_amdgcn_s_waitcnt(0);
        unsigned nloc = b.st[0], nx = b.st[1];
        if (nloc == 0u) { xcd_barrier_complete(bar, b.x, nloc, nx); b.st[0] = nloc; b.st[1] = nx; }
        const unsigned old = xb_add(&bar[XB_XSUB(b.x)], 1u);
        const unsigned gen = old / nloc;
        if (old + 1u == (gen + 1u) * nloc) {
            __builtin_amdgcn_fence(__ATOMIC_RELEASE, "agent");
            asm volatile("s_waitcnt vmcnt(0)" ::: "memory");
            const unsigned og = xb_add(&bar[XB_TOP], 1u);
            const unsigned tg = og / nx;
            if (og + 1u == (tg + 1u) * nx) xb_add(&bar[XB_TOPGEN], 1u);
            else XB_SPIN(xb_ld(&bar[XB_TOPGEN]) == tg, bar);
            __builtin_amdgcn_fence(__ATOMIC_ACQUIRE, "agent");
            xb_add(&bar[XB_XGEN(b.x)], 1u);
            asm volatile("s_waitcnt vmcnt(0)" ::: "memory");
        } else {
            XB_SPIN(xb_ld(&bar[XB_XGEN(b.x)]) == gen, bar);
            __builtin_amdgcn_fence(__ATOMIC_ACQUIRE, "agent");
            asm volatile("s_waitcnt vmcnt(0)" ::: "memory");
        }
    }
    __syncthreads();
}
#define ATT_THR 8.0f
#ifndef ATT_PRIO
#define ATT_PRIO 1
#endif
#ifndef ATT_DMA_REP
#define ATT_DMA_REP 1
#endif
#define MAXF(a, b) __builtin_amdgcn_fmed3f((a), (b), __builtin_inff())
#define MFMA32(a, b, c) __builtin_amdgcn_mfma_f32_32x32x16_bf16((a), (b), (c), 0, 0, 0)
__device__ __forceinline__ float att_rowmax(const f32x16& p0, const f32x16& p1) {
    float a = MAXF(p0[0], p1[0]), b = MAXF(p0[1], p1[1]);
#pragma unroll
    for (int r = 2; r < 16; r += 2) { a = MAXF(MAXF(a, p0[r]), p1[r]); b = MAXF(MAXF(b, p0[r + 1]), p1[r + 1]); }
    a = MAXF(a, b);
    auto rr = __builtin_amdgcn_permlane32_swap(__float_as_uint(a), __float_as_uint(a), false, false);
    return MAXF(__uint_as_float(rr[0]), __uint_as_float(rr[1]));
}
__device__ __forceinline__ void attn_unit(int b, int h, int qb, const bf16_t* PROJ, const bf16_t* VT, bf16_t* MIX, float lam, const float* subg, LAS unsigned char* lds, int tid, int lane, int wave) {
    const int r32 = lane & 31, hi = lane >> 5, comp = wave >> 2, wq = wave & 3;
    const size_t tok0 = (size_t)b * SEQ + 128 * qb;
    bf16x8 qr[4];
    { const bf16_t* qp = PROJ + (tok0 + 32 * wq + r32) * PROJW + 2048 + h * 128 + comp * 64 + 8 * hi;
#pragma unroll
      for (int d0 = 0; d0 < 4; ++d0) qr[d0] = *(const bf16x8*)(qp + 16 * d0); }
    const int NT = 2 * qb + 2, my_nt = wq < 2 ? NT - 1 : NT;
    const bf16_t* gK0; const bf16_t* gV0;
    { const int krow = (tid >> 3) & 63, sw = tid & 7, chunk = sw ^ ((krow >> 1) & 7); gK0 = PROJ + ((size_t)b * SEQ + krow) * PROJW + 3072 + h * 128 + chunk * 8;
      gV0 = VT + (size_t)(h * 128 + krow) * MTOK + (size_t)b * SEQ + chunk * 8; }
    const int pr = (r32 & 19) | ((r32 & 4) << 1) | ((r32 & 8) >> 1);
    int koff[4], voff[4];
#pragma unroll
    for (int d0 = 0; d0 < 4; ++d0) { koff[d0] = comp * 8192 + pr * 128 + (((2 * d0 + hi) ^ ((pr >> 1) & 7)) << 4); voff[d0] = r32 * 128 + (((2 * d0 + hi) ^ ((r32 >> 1) & 7)) << 4); }
    f32x16 o[4]; o[0] = f32x16{}; o[1] = f32x16{}; o[2] = f32x16{}; o[3] = f32x16{};
    f32x16 negm = f32x16{};
    float l_run = 0.f;
    u32x4 pw[4];
#define ATT_DMA(t) do { LAS unsigned char* ks_ = lds + ((t) % 3) * 16384 + wave * 1024; LAS unsigned char* vs_ = lds + 49152 + ((t) & 3) * 16384 + wave * 1024; \
        _Pragma("unroll") for (int i_ = 0; i_ < 2 * ATT_DMA_REP; ++i_) { const int i = i_ & 1; \
            __builtin_amdgcn_global_load_lds((const unsigned*)(gK0 + (size_t)(t) * 64 * PROJW + i * 64), (LAS unsigned*)(ks_ + i * 8192), 16, 0, 0); \
            __builtin_amdgcn_global_load_lds((const unsigned*)(gV0 + (size_t)(t) * 64 + (size_t)i * 64 * MTOK), (LAS unsigned*)(vs_ + i * 8192), 16, 0, 0); } } while (0)
#define ATT_STAGE(t) do { if ((t) + 1 < NT) { if (ATT_DMA_REP == 1) asm volatile("s_waitcnt vmcnt(4)" ::: "memory"); else asm volatile("s_waitcnt vmcnt(8)" ::: "memory"); } else asm volatile("s_waitcnt vmcnt(0)" ::: "memory"); \
        __builtin_amdgcn_s_barrier(); asm volatile("" ::: "memory"); if ((t) + 2 < NT) ATT_DMA((t) + 2); } while (0)
#define ATT_LDK(KF, KST) do { _Pragma("unroll") for (int d0 = 0; d0 < 4; ++d0) { KF[2 * d0] = *(const LAS bf16x8*)((KST) + koff[d0]); KF[2 * d0 + 1] = *(const LAS bf16x8*)((KST) + koff[d0] + 4096); } } while (0)
#define ATT_LDV(VF, VST, BLK) do { _Pragma("unroll") for (int s = 0; s < 4; ++s) VF[s] = *(const LAS bf16x8*)((VST) + voff[s] + (BLK) * 4096); } while (0)
#define ATT_QK(P0, P1, KF) do { P0 = MFMA32(KF[0], qr[0], negm); P1 = MFMA32(KF[1], qr[0], negm); \
        _Pragma("unroll") for (int d0 = 1; d0 < 4; ++d0) { P0 = MFMA32(KF[2 * d0], qr[d0], P0); P1 = MFMA32(KF[2 * d0 + 1], qr[d0], P1); } } while (0)
#define ATT_PV(VF, BLK) do { _Pragma("unroll") for (int s = 0; s < 4; ++s) o[BLK] = MFMA32(VF[s], __builtin_bit_cast(bf16x8, pw[s]), o[BLK]); } while (0)
#define ATT_EXP_PACK(P0, P1, PW) do { float ls0 = 0.f, ls1 = 0.f; \
        _Pragma("unroll") for (int r = 0; r < 16; ++r) { P0[r] = __builtin_amdgcn_exp2f(P0[r]); P1[r] = __builtin_amdgcn_exp2f(P1[r]); } \
        _Pragma("unroll") for (int r = 0; r < 16; r += 2) { ls0 += P0[r] + P1[r]; ls1 += P0[r + 1] + P1[r + 1]; } \
        l_run += ls0 + ls1; \
        PW[0] = (u32x4){pk2(P0[0], P0[1]), pk2(P0[2], P0[3]), pk2(P0[4], P0[5]), pk2(P0[6], P0[7])}; PW[1] = (u32x4){pk2(P0[8], P0[9]), pk2(P0[10], P0[11]), pk2(P0[12], P0[13]), pk2(P0[14], P0[15])}; \
        PW[2] = (u32x4){pk2(P1[0], P1[1]), pk2(P1[2], P1[3]), pk2(P1[4], P1[5]), pk2(P1[6], P1[7])}; PW[3] = (u32x4){pk2(P1[8], P1[9]), pk2(P1[10], P1[11]), pk2(P1[12], P1[13]), pk2(P1[14], P1[15])}; } while (0)
    ATT_DMA(0); ATT_DMA(1);
    ATT_STAGE(0);
    {
        bf16x8 kf[8]; ATT_LDK(kf, lds);
        f32x16 p0, p1; ATT_QK(p0, p1, kf);
        const float rm = att_rowmax(p0, p1);
#pragma unroll
        for (int r = 0; r < 16; ++r) { p0[r] -= rm; p1[r] -= rm; negm[r] = -rm; }
        ATT_EXP_PACK(p0, p1, pw);
    }
    for (int t = 1; t < my_nt; ++t) {
        ATT_STAGE(t);
        const LAS unsigned char* kst = lds + (t % 3) * 16384;
        const LAS unsigned char* vpr = lds + 49152 + ((t - 1) & 3) * 16384;
        bf16x8 kf[8], v0[4], v1[4], v2[4], v3[4];
        ATT_LDK(kf, kst); ATT_LDV(v0, vpr, 0);
        __builtin_amdgcn_sched_barrier(0);
        __builtin_amdgcn_s_setprio(ATT_PRIO);
        f32x16 p0, p1; ATT_QK(p0, p1, kf);
        __builtin_amdgcn_sched_barrier(0);
        ATT_LDV(v1, vpr, 1); ATT_LDV(v2, vpr, 2);
        ATT_PV(v0, 0); ATT_PV(v1, 1);
        __builtin_amdgcn_sched_barrier(0);
        ATT_LDV(v3, vpr, 3);
        const float rm = att_rowmax(p0, p1);
        float fsc = 1.f; const bool resc = __any(rm > ATT_THR);
        if (__builtin_expect(resc, 0)) { const float dl = fmaxf(rm, 0.f); fsc = __builtin_amdgcn_exp2f(-dl); l_run *= fsc;
#pragma unroll
            for (int r = 0; r < 16; ++r) { p0[r] -= dl; p1[r] -= dl; negm[r] -= dl; } }
        ATT_PV(v2, 2); ATT_PV(v3, 3);
        __builtin_amdgcn_s_setprio(0);
        ATT_EXP_PACK(p0, p1, pw);
        if (__builtin_expect(resc, 0)) {
#pragma unroll
            for (int blk = 0; blk < 4; ++blk)
#pragma unroll
                for (int r = 0; r < 16; ++r) o[blk][r] *= fsc; }
    }
    if (my_nt < NT) ATT_STAGE(NT - 1);
    { const LAS unsigned char* vpr = lds + 49152 + ((my_nt - 1) & 3) * 16384; bf16x8 v0[4], v1[4], v2[4], v3[4]; ATT_LDV(v0, vpr, 0); ATT_LDV(v1, vpr, 1); ATT_LDV(v2, vpr, 2); ATT_LDV(v3, vpr, 3); ATT_PV(v0, 0); ATT_PV(v1, 1); ATT_PV(v2, 2); ATT_PV(v3, 3); }
    const float l_tot = swap_add(l_run); float inv = 1.0f / l_tot; if (comp == 1) inv *= lam;
    LAS float* comb = (LAS float*)lds;
    __syncthreads();
    if (comp == 1) {
#pragma unroll
        for (int blk = 0; blk < 4; ++blk)
#pragma unroll
            for (int q = 0; q < 4; ++q) { f32x4 v = {o[blk][4 * q] * inv, o[blk][4 * q + 1] * inv, o[blk][4 * q + 2] * inv, o[blk][4 * q + 3] * inv};
                *(LAS f32x4*)(comb + (32 * wq + r32) * 132 + 32 * blk + 8 * q + 4 * hi) = v; }
    }
    __syncthreads();
    if (comp == 0) {
        float ss = 0.f;
#pragma unroll
        for (int blk = 0; blk < 4; ++blk)
#pragma unroll
            for (int q = 0; q < 4; ++q) { const f32x4 c = *(const LAS f32x4*)(comb + (32 * wq + r32) * 132 + 32 * blk + 8 * q + 4 * hi);
#pragma unroll
                for (int e = 0; e < 4; ++e) { const float d = o[blk][4 * q + e] * inv - c[e]; o[blk][4 * q + e] = d; ss += d * d; } }
        ss = swap_add(ss);
        const float rn = (1.0f - LAM_INIT) / sqrtf(ss * (1.0f / 128.0f) + LN_EPS);
        bf16_t* op = MIX + (tok0 + 32 * wq + r32) * DM + 1024 + h * 128;
#pragma unroll
        for (int blk = 0; blk < 4; ++blk)
#pragma unroll
            for (int q = 0; q < 4; ++q) { const int dv = 32 * blk + 8 * q + 4 * hi; const f32x4 sg = *(const f32x4*)(subg + dv);
                u32x2 w; w.x = pk2(o[blk][4 * q] * rn * sg[0], o[blk][4 * q + 1] * rn * sg[1]); w.y = pk2(o[blk][4 * q + 2] * rn * sg[2], o[blk][4 * q + 3] * rn * sg[3]);
                *(u32x2*)(op + dv) = w; }
    }
    __syncthreads();
#undef ATT_STAGE
#undef ATT_DMA
#undef ATT_QK
#undef ATT_PV
#undef ATT_LDK
#undef ATT_LDV
#undef ATT_EXP_PACK
}
#ifndef GEMM_SP2
#define GEMM_SP2 true
#endif
#ifndef REP_P0
#define REP_P0 1
#endif
#ifndef REP_P1
#define REP_P1 1
#endif
#ifndef REP_P2
#define REP_P2 1
#endif
#ifndef REP_P3
#define REP_P3 1
#endif
#ifndef REP_P5
#define REP_P5 1
#endif
#ifndef REP_P7A
#define REP_P7A 1
#endif
#ifndef REP_P7G
#define REP_P7G 1
#endif
#ifndef EXTRA_SYNCS
#define EXTRA_SYNCS 0
#endif
#define GEMM_MULTI(EPI, g, E) do { int bx_ = blockIdx.x; asm volatile("" : "+s"(bx_)); pg8::StaticOrder S_; S_.init((g).M, (g).N, (int)gridDim.x, bx_); pg8::gemm_phase<EPI, pg8::StaticOrder, true, GEMM_SP2>(lds3, g, S_, E); } while (0)

__global__ void __launch_bounds__(NWAVES * 64, 2) fwd_megakernel(Args args) {
    extern __shared__ __attribute__((aligned(16))) unsigned char lds[];
    cg::grid_group grid = cg::this_grid();
    LAS unsigned char* lds3 = (LAS unsigned char*)lds;
    volatile LAS unsigned* xst = (volatile LAS unsigned*)(lds3 + LDS_BYTES - 64);
    if (threadIdx.x < 2) xst[threadIdx.x] = 0u;
    __syncthreads();
    const XcdBarrier xbar = xcd_barrier_post((unsigned*)(args.ws + WS_CTL), xst);
#define GRID_BAR() xcd_barrier(xbar)
#define PHASE_IDS() int tid = threadIdx.x; asm volatile("" : "+v"(tid)); const int lane = tid & 63, wave = __builtin_amdgcn_readfirstlane(tid >> 6); (void)lane; (void)wave
    unsigned char* ws = args.ws;
    float* mod = (float*)(ws + WS_MOD);
    bf16_t* H = (bf16_t*)(ws + WS_H); bf16_t* HID = (bf16_t*)(ws + WS_HID); bf16_t* PROJ = (bf16_t*)(ws + WS_PROJ); bf16_t* VT = (bf16_t*)(ws + WS_VT); bf16_t* MIX = (bf16_t*)(ws + WS_MIX);
    float* out = args.out; const float* x = args.in[0];
    bf16_t* TB = (bf16_t*)(ws + WS_T); float* stats = (float*)(ws + WS_STATS);

    for (int rep_ = 0; rep_ < REP_P0; ++rep_) { PHASE_IDS(); p0_prologue(args, lds3, tid, lane, wave); }
    for (int rep_ = 0; rep_ < EXTRA_SYNCS; ++rep_) GRID_BAR();
    grid.sync();
    for (int rep_ = 0; rep_ < REP_P1; ++rep_) { PHASE_IDS(); row_pass<0>(x, nullptr, H, nullptr, nullptr, mod + 0 * DM, mod + 1 * DM, lane, wave); }
    GRID_BAR();
    for (int rep_ = 0; rep_ < REP_P2; ++rep_) { pg8::Gemm g{H, (const bf16_t*)(ws + WS_WGU1), MTOK, 2 * DFF, DM}; pg8::EpiSwiglu E{HID, DFF}; GEMM_MULTI(pg8::EpiSwiglu, g, E); }
    GRID_BAR();
    for (int rep_ = 0; rep_ < REP_P3; ++rep_) { pg8::Gemm g{HID, (const bf16_t*)(ws + WS_WD1), MTOK, DM, DFF}; pg8::EpiResidBf<true> E{x, nullptr, nullptr, nullptr, nullptr, TB, mod + 2 * DM, ALPHA, 0.5f}; GEMM_MULTI(pg8::EpiResidBf<true>, g, E); }
    GRID_BAR();
    { PHASE_IDS(); ln_pass<false>(TB, stats, H, nullptr, args.in[6], args.in[7], mod + 3 * DM, mod + 4 * DM, lane, wave); }
    GRID_BAR();
    for (int rep_ = 0; rep_ < REP_P5; ++rep_) {
    { pg8::Gemm g{H, (const bf16_t*)(ws + WS_WIN), MTOK, PROJW, DM}; pg8::EpiProj E{PROJ, PROJW, 1, (const float*)(ws + WS_ROPE), (float*)(ws + WS_PART), QSCALE}; GEMM_MULTI(pg8::EpiProj, g, E); }
    { pg8::Gemm g{(const bf16_t*)(ws + WS_WIN) + (size_t)PROJW * DM, H, 1024, MTOK, DM}; pg8::EpiProj E{VT, MTOK, 0, nullptr, nullptr, 1.0f}; GEMM_MULTI(pg8::EpiProj, g, E); }
    }
    GRID_BAR();
    {
        PHASE_IDS();
        const int bx = blockIdx.x, G = gridDim.x; const int vcu = (G % 8 == 0) ? (bx % 8) * (G / 8) + bx / 8 : bx;
        float lam;
        { const float a1 = lane < 64 ? args.in[13][lane] * args.in[14][lane] : 0.f, a2 = args.in[15][lane] * args.in[16][lane];
          lam = __expf(wave_sum(a1)) - __expf(wave_sum(a2)) + LAM_INIT; }
        for (int rep_ = 0; rep_ < REP_P7A; ++rep_)
        for (int P2 = 2 * vcu; P2 < 1024; P2 += (P2 & 1) ? 2 * G - 1 : 1) {
            const int P = P2 >> 1, bh = P >> 5, s = P & 31;
            attn_unit(bh >> 3, bh & 7, (P2 & 1) ? s : 63 - s, PROJ, VT, MIX, lam, args.in[17], lds3, tid, lane, wave);
        }
        for (int rep_ = 0; rep_ < REP_P7G; ++rep_)
        for (int u = vcu; u < 1024; u += G) gmlp_unit(u, PROJ, (const float*)(ws + WS_PART), args.in[9], args.in[10], args.in[11], args.in[12], MIX, lds3, tid, lane, wave);
    }
    GRID_BAR();
    { pg8::Gemm g{MIX, (const bf16_t*)(ws + WS_WOUT), MTOK, DM, DM}; pg8::EpiResidBf<false> E{nullptr, TB, stats, args.in[6], args.in[7], TB, mod + 5 * DM, ALPHA, 1.0f}; GEMM_MULTI(pg8::EpiResidBf<false>, g, E); }
    GRID_BAR();
    { PHASE_IDS(); ln_pass<false>(TB, stats, H, nullptr, args.in[19], args.in[20], mod + 6 * DM, mod + 7 * DM, lane, wave); }
    GRID_BAR();
    { pg8::Gemm g{H, (const bf16_t*)(ws + WS_WGU2), MTOK, 2 * DFF, DM}; pg8::EpiSwiglu E{HID, DFF}; GEMM_MULTI(pg8::EpiSwiglu, g, E); }
    GRID_BAR();
    { pg8::Gemm g{HID, (const bf16_t*)(ws + WS_WD2), MTOK, DM, DFF}; pg8::EpiResidBf<false> E{nullptr, TB, stats, args.in[19], args.in[20], TB, mod + 8 * DM, ALPHA, 0.5f}; GEMM_MULTI(pg8::EpiResidBf<false>, g, E); }
    GRID_BAR();
    { PHASE_IDS(); ln_pass<true>(TB, nullptr, nullptr, out, args.in[23], args.in[24], nullptr, nullptr, lane, wave); }
}

extern "C" void kernel_launch(void* const* d_in, const int* in_sizes, int n_in, void* d_out, int out_size, void* d_ws, size_t ws_size, hipStream_t stream) {
    static int grid = 0;
    if (grid == 0) {
        if (n_in != 25 || in_sizes[0] != MTOK * DM || out_size != MTOK * DM || ws_size < WS_END2) { fprintf(stderr, "kernel_launch: unexpected shapes (n_in %d, in0 %d, out %d, ws %zu)\n", n_in, n_in > 0 ? in_sizes[0] : -1, out_size, ws_size); grid = -1; return; }
        int dev = 0, cus = 0, per_cu = 0;
        hipGetDevice(&dev); hipDeviceGetAttribute(&cus, hipDeviceAttributeMultiprocessorCount, dev);
        if (hipFuncSetAttribute((const void*)fwd_megakernel, hipFuncAttributeMaxDynamicSharedMemorySize, LDS_BYTES) != hipSuccess) { fprintf(stderr, "kernel_launch: hipFuncSetAttribute failed\n"); grid = -1; return; }
        hipOccupancyMaxActiveBlocksPerMultiprocessor(&per_cu, (const void*)fwd_megakernel, NWAVES * 64, LDS_BYTES);
        (void)hipGetLastError();
        if (per_cu < 1) per_cu = 1;
        grid = cus * 1;
    }
    if (grid < 0) return;
    if (hipMemsetAsync((char*)d_ws + WS_CTL, 0, CTL_BYTES, stream) != hipSuccess) { fprintf(stderr, "kernel_launch: hipMemsetAsync failed\n"); return; }
    Args a{};
    for (int i = 0; i < 25; ++i) a.in[i] = (const float*)d_in[i];
    a.out = (float*)d_out; a.ws = (unsigned char*)d_ws;
    void* kargs[] = {&a};
    hipError_t e = hipLaunchCooperativeKernel((const void*)fwd_megakernel, dim3(grid), dim3(NWAVES * 64), kargs, LDS_BYTES, stream);
    if (e != hipSuccess) fprintf(stderr, "cooperative launch failed: %s (grid %d)\n", hipGetErrorString(e), grid);
}
```
